# Optimizing an MI355X kernel written in HIP

```python
import jax, jax.numpy as jnp
from jax import lax
import numpy as np

D_MODEL = 1024
BATCH = 2
SEQ = 8192
DEPTH = 2

HEAD_DIM = 64
ROPE_THETA = 10000.0
NORM_EPS = 1e-6
A_HEADS = 8
IDX_HEADS = 4
IDX_DIM = 64
IDX_TOPK_MAX = 256
B_HEADS = 8
B_KV_HEADS = 2
WINDOW = 128
C_HEADS = 8
MOBA_BLOCK = 256
MOBA_TOPK = 3
C_Q_CHUNK = 64
Q_BLOCK = 128
N_BRANCH = 3
BRANCH_WIDTH = 8 * HEAD_DIM
D_FF = 4 * D_MODEL
IN_SIZES = (
    A_HEADS * HEAD_DIM, HEAD_DIM, HEAD_DIM,
    IDX_HEADS * IDX_DIM, IDX_DIM, IDX_HEADS,
    B_HEADS * HEAD_DIM, B_KV_HEADS * HEAD_DIM, B_KV_HEADS * HEAD_DIM,
    C_HEADS * HEAD_DIM, C_HEADS * HEAD_DIM, C_HEADS * HEAD_DIM,
    N_BRANCH * D_MODEL,
)
N_IN = sum(IN_SIZES)

kernel_name = 'hybrid_dsa_swa_moba_gated_block'


def rms_norm(x, g):
    xf = x.astype(jnp.float32)
    y = xf * lax.rsqrt(jnp.mean(xf * xf, axis=-1, keepdims=True) + NORM_EPS)
    return (y * g.astype(jnp.float32)).astype(x.dtype)


def rope_tables(seq, dim):
    inv = 1.0 / (ROPE_THETA ** (jnp.arange(0, dim, 2, dtype=jnp.float32) / dim))
    ang = jnp.arange(seq, dtype=jnp.float32)[:, None] * inv[None, :]
    return jnp.cos(ang), jnp.sin(ang)


def apply_rope(x, cos, sin):
    half = x.shape[-1] // 2
    x1, x2 = x[..., :half], x[..., half:]
    c = cos[None, :, None, :].astype(x.dtype)
    s = sin[None, :, None, :].astype(x.dtype)
    return jnp.concatenate([x1 * c - x2 * s, x1 * s + x2 * c], axis=-1)


def dsa_attention(q, k, v, q_idx, k_idx, w_idx):
    b, s, h, d = q.shape
    top_k = min(IDX_TOPK_MAX, s // 4)
    key_pos = jnp.arange(s)
    idx_scale = (IDX_DIM ** -0.5) * (IDX_HEADS ** -0.5)
    att_scale = d ** -0.5

    def one_block(i):
        start = i * Q_BLOCK
        qb = lax.dynamic_slice_in_dim(q, start, Q_BLOCK, axis=1)
        qib = lax.dynamic_slice_in_dim(q_idx, start, Q_BLOCK, axis=1)
        wb = lax.dynamic_slice_in_dim(w_idx, start, Q_BLOCK, axis=1)
        qpos = start + jnp.arange(Q_BLOCK)
        dots = jnp.einsum('bqhe,bse->bqhs', qib, k_idx).astype(jnp.float32)
        score = jnp.einsum('bqh,bqhs->bqs', wb.astype(jnp.float32), jax.nn.relu(dots)) * idx_scale
        causal = key_pos[None, :] <= qpos[:, None]
        score = jnp.where(causal[None], score, -jnp.inf)
        _, sel = lax.top_k(score, top_k)
        valid = sel <= qpos[None, :, None]
        k_sel = jax.vmap(lambda kk, ii: kk[ii])(k, sel)
        v_sel = jax.vmap(lambda vv, ii: vv[ii])(v, sel)
        logits = jnp.einsum('bqhd,bqkd->bqhk', qb, k_sel).astype(jnp.float32) * att_scale
        logits = jnp.where(valid[:, :, None, :], logits, -jnp.inf)
        p = jax.nn.softmax(logits, axis=-1).astype(v.dtype)
        return jnp.einsum('bqhk,bqkd->bqhd', p, v_sel)

    out = lax.map(one_block, jnp.arange(s // Q_BLOCK))
    return out.transpose(1, 0, 2, 3, 4).reshape(b, s, h * d)


def swa_sink_attention(q, k, v, sinks):
    b, s, hq, d = q.shape
    hkv = k.shape[2]
    g = hq // hkv
    nq = s // WINDOW
    qb = q.reshape(b, nq, WINDOW, hkv, g, d)
    pad = ((0, 0), (WINDOW, 0), (0, 0), (0, 0))
    kp = jnp.pad(k, pad).reshape(b, nq + 1, WINDOW, hkv, d)
    vp = jnp.pad(v, pad).reshape(b, nq + 1, WINDOW, hkv, d)
    kb = jnp.concatenate([kp[:, :-1], kp[:, 1:]], axis=2)
    vb = jnp.concatenate([vp[:, :-1], vp[:, 1:]], axis=2)
    logits = jnp.einsum('bnqhgd,bnkhd->bnhgqk', qb, kb).astype(jnp.float32) * (d ** -0.5)
    qpos = jnp.arange(nq)[:, None] * WINDOW + jnp.arange(WINDOW)[None, :]
    kpos = jnp.arange(nq)[:, None] * WINDOW - WINDOW + jnp.arange(2 * WINDOW)[None, :]
    diff = qpos[:, :, None] - kpos[:, None, :]
    mask = (diff >= 0) & (diff < WINDOW) & (kpos[:, None, :] >= 0)
    logits = jnp.where(mask[None, :, None, None], logits, -jnp.inf)
    sink = sinks.astype(jnp.float32).reshape(hkv, g)[None, None, :, :, None, None]
    sink = jnp.broadcast_to(sink, logits.shape[:-1] + (1,))
    p = jax.nn.softmax(jnp.concatenate([logits, sink], axis=-1), axis=-1)[..., :-1]
    out = jnp.einsum('bnhgqk,bnkhd->bnqhgd', p.astype(v.dtype), vb)
    return out.reshape(b, s, hq * d)


def moba_attention(q, k, v):
    b, s, h, d = q.shape
    nkb = -(-s // MOBA_BLOCK)
    pad = nkb * MOBA_BLOCK - s
    padw = ((0, 0), (0, pad), (0, 0), (0, 0))
    kbl = jnp.pad(k, padw).reshape(b, nkb, MOBA_BLOCK, h, d).transpose(0, 3, 1, 2, 4)
    vbl = jnp.pad(v, padw).reshape(b, nkb, MOBA_BLOCK, h, d).transpose(0, 3, 1, 2, 4)
    kmean = jnp.mean(kbl.astype(jnp.float32), axis=3)
    n_sel = min(MOBA_TOPK, nkb - 1)
    scale = d ** -0.5
    bi = jnp.arange(b)[:, None, None, None]
    hi = jnp.arange(h)[None, :, None, None]
    blk_ids = jnp.arange(nkb)

    def one_chunk(c):
        start = c * C_Q_CHUNK
        qc = lax.dynamic_slice_in_dim(q, start, C_Q_CHUNK, axis=1).transpose(0, 2, 1, 3)
        qpos = start + jnp.arange(C_Q_CHUNK)
        own = start // MOBA_BLOCK
        k_own = lax.dynamic_index_in_dim(kbl, own, axis=2, keepdims=False)
        v_own = lax.dynamic_index_in_dim(vbl, own, axis=2, keepdims=False)
        kpos_own = own * MOBA_BLOCK + jnp.arange(MOBA_BLOCK)
        l_own = jnp.einsum('bhqd,bhkd->bhqk', qc, k_own).astype(jnp.float32) * scale
        l_own = jnp.where((kpos_own[None, :] <= qpos[:, None])[None, None], l_own, -jnp.inf)
        if n_sel == 0:
            p_own = jax.nn.softmax(l_own, axis=-1).astype(v.dtype)
            out = jnp.einsum('bhqk,bhkd->bhqd', p_own, v_own)
            return out.transpose(0, 2, 1, 3)
        gate = jnp.einsum('bhqd,bhnd->bhqn', qc.astype(jnp.float32), kmean)
        gate = jnp.where((blk_ids < own)[None, None, None, :], gate, -jnp.inf)
        _, sel = lax.top_k(gate, n_sel)
        valid = sel < own
        k_sel = kbl[bi, hi, sel]
        v_sel = vbl[bi, hi, sel]
        l_sel = jnp.einsum('bhqd,bhqnkd->bhqnk', qc, k_sel).astype(jnp.float32) * scale
        l_sel = jnp.where(valid[..., None], l_sel, -jnp.inf).reshape(b, h, C_Q_CHUNK, n_sel * MOBA_BLOCK)
        p = jax.nn.softmax(jnp.concatenate([l_sel, l_own], axis=-1), axis=-1).astype(v.dtype)
        p_sel = p[..., :n_sel * MOBA_BLOCK].reshape(b, h, C_Q_CHUNK, n_sel, MOBA_BLOCK)
        p_own = p[..., n_sel * MOBA_BLOCK:]
        out = (jnp.einsum('bhqnk,bhqnkd->bhqd', p_sel, v_sel)
               + jnp.einsum('bhqk,bhkd->bhqd', p_own, v_own))
        return out.transpose(0, 2, 1, 3)

    out = lax.map(one_chunk, jnp.arange(s // C_Q_CHUNK))
    return out.transpose(1, 0, 2, 3, 4).reshape(b, s, h * d)


def hybrid_layer(x, cos, sin, norm1, w_in, sinks, w_branch, w_out, norm2, w_ff1, w_ff2):
    b, s, _ = x.shape
    h = rms_norm(x, norm1)
    proj = h @ w_in
    split_points = np.cumsum(np.array(IN_SIZES))[:-1].tolist()
    (aq, ak, av, iq, ik, iw, bq, bk, bv, cq, ck, cv, gates) = jnp.split(proj, split_points, axis=-1)

    aq = apply_rope(aq.reshape(b, s, A_HEADS, HEAD_DIM), cos, sin)
    ak = apply_rope(ak[:, :, None, :], cos, sin)[:, :, 0, :]
    iq = apply_rope(iq.reshape(b, s, IDX_HEADS, IDX_DIM), cos, sin)
    ik = apply_rope(ik[:, :, None, :], cos, sin)[:, :, 0, :]
    o_a = dsa_attention(aq, ak, av, iq, ik, iw)

    bq = apply_rope(bq.reshape(b, s, B_HEADS, HEAD_DIM), cos, sin)
    bk = apply_rope(bk.reshape(b, s, B_KV_HEADS, HEAD_DIM), cos, sin)
    bv = bv.reshape(b, s, B_KV_HEADS, HEAD_DIM)
    o_b = swa_sink_attention(bq, bk, bv, sinks)

    cq = apply_rope(cq.reshape(b, s, C_HEADS, HEAD_DIM), cos, sin)
    ck = apply_rope(ck.reshape(b, s, C_HEADS, HEAD_DIM), cos, sin)
    cv = cv.reshape(b, s, C_HEADS, HEAD_DIM)
    o_c = moba_attention(cq, ck, cv)

    branches = jnp.stack([o_a, o_b, o_c], axis=2)
    g = jax.nn.sigmoid(gates.reshape(b, s, N_BRANCH, D_MODEL))
    merged = jnp.sum(g * jnp.einsum('bsnc,ncd->bsnd', branches, w_branch), axis=2)
    x = x + merged @ w_out

    h2 = rms_norm(x, norm2)
    x = x + jnp.square(jax.nn.relu(h2 @ w_ff1)) @ w_ff2
    return x


def setup_inputs(seed: int = 0) -> dict:
    key = jax.random.key(seed)
    ks = jax.random.split(key, 10)
    f32 = jnp.float32
    x = jax.random.normal(ks[0], (BATCH, SEQ, D_MODEL), f32)
    norm1 = 1.0 + 0.01 * jax.random.normal(ks[1], (DEPTH, D_MODEL), f32)
    w_in = jax.random.normal(ks[2], (DEPTH, D_MODEL, N_IN), f32) * D_MODEL ** -0.5
    sinks = 0.5 * jax.random.normal(ks[3], (DEPTH, B_HEADS), f32)
    w_branch = jax.random.normal(ks[4], (DEPTH, N_BRANCH, BRANCH_WIDTH, D_MODEL), f32) * BRANCH_WIDTH ** -0.5
    w_out = jax.random.normal(ks[5], (DEPTH, D_MODEL, D_MODEL), f32) * D_MODEL ** -0.5
    norm2 = 1.0 + 0.01 * jax.random.normal(ks[6], (DEPTH, D_MODEL), f32)
    w_ff1 = jax.random.normal(ks[7], (DEPTH, D_MODEL, D_FF), f32) * D_MODEL ** -0.5
    w_ff2 = jax.random.normal(ks[8], (DEPTH, D_FF, D_MODEL), f32) * D_FF ** -0.5
    norm_f = 1.0 + 0.01 * jax.random.normal(ks[9], (D_MODEL,), f32)
    return {'x': x, 'norm1': norm1, 'w_in': w_in, 'sinks': sinks, 'w_branch': w_branch,
            'w_out': w_out, 'norm2': norm2, 'w_ff1': w_ff1, 'w_ff2': w_ff2, 'norm_f': norm_f}


def reference(x, norm1, w_in, sinks, w_branch, w_out, norm2, w_ff1, w_ff2, norm_f):
    cos, sin = rope_tables(x.shape[1], HEAD_DIM)
    for l in range(DEPTH):
        x = hybrid_layer(x, cos, sin, norm1[l], w_in[l], sinks[l], w_branch[l], w_out[l],
                         norm2[l], w_ff1[l], w_ff2[l])
    return rms_norm(x, norm_f)
```

```cpp
#include <hip/hip_runtime.h>
#include <stdint.h>

typedef unsigned short bf16_t;
#define DEVI __device__ __forceinline__

constexpr int BATCH = 2, SEQ = 8192, DMODEL = 1024, M = BATCH * SEQ, NIN = 6340, DFF = 4096;
constexpr int NPROJ = 3268;
constexpr float EPS = 1e-6f;
constexpr float C2 = 0.125f * 1.4426950408889634f;
constexpr float LOG2E = 1.4426950408889634f;

constexpr size_t MiB = 1u << 20;
constexpr size_t WS_CTL = 0;
constexpr size_t WS_SSQ = 1 * MiB;
constexpr size_t WS_IW = 2 * MiB;
constexpr size_t WS_KMEAN = 2 * MiB + 512 * 1024;
constexpr size_t WS_COS = 3 * MiB, WS_SIN = 4 * MiB;
constexpr size_t WS_W = 6 * MiB;
constexpr size_t WS_XG = 40 * MiB;
constexpr size_t WS_AQ = 72 * MiB, WS_BQ = 88 * MiB, WS_CQ = 104 * MiB;
constexpr size_t WS_AK = 120 * MiB, WS_AV = 122 * MiB, WS_IQ = 124 * MiB, WS_IK = 132 * MiB;
constexpr size_t WS_BK = 134 * MiB, WS_BV = 138 * MiB, WS_CK = 142 * MiB, WS_CV = 158 * MiB;
constexpr size_t WS_GS = 120 * MiB;
constexpr size_t WS_MG = 216 * MiB;
constexpr size_t WS_U = 120 * MiB;
constexpr size_t WS_SEL = 248 * MiB;

DEVI float bf2f(bf16_t v) { return __uint_as_float((unsigned)v << 16); }
DEVI bf16_t f2bf(float f) { unsigned u = __float_as_uint(f); return (bf16_t)((u + 0x7fffu + ((u >> 16) & 1u)) >> 16); }
DEVI float wave_sum(float v) {
#pragma unroll
    for (int o = 1; o < 64; o <<= 1) v += __shfl_xor(v, o);
    return v;
}
DEVI float wave_max(float v) {
#pragma unroll
    for (int o = 1; o < 64; o <<= 1) v = fmaxf(v, __shfl_xor(v, o));
    return v;
}
DEVI float rstd_of(const float* ssq, int m) {
    const float4* p = (const float4*)(ssq + (size_t)m * 16);
    float4 a = p[0], b = p[1], c = p[2], d = p[3];
    float s = ((a.x + a.y) + (a.z + a.w)) + ((b.x + b.y) + (b.z + b.w)) + ((c.x + c.y) + (c.z + c.w)) + ((d.x + d.y) + (d.z + d.w));
    return rsqrtf(s * (1.0f / DMODEL) + EPS);
}

__device__ const double INVF[32] = {
    1.00000000000000000e+00, 7.49894209332455874e-01, 5.62341325190349073e-01, 4.21696503428582226e-01,
    3.16227766016837941e-01, 2.37137370566165517e-01, 1.77827941003892293e-01, 1.33352143216332403e-01,
    1.00000000000000006e-01, 7.49894209332455791e-02, 5.62341325190349114e-02, 4.21696503428582239e-02,
    3.16227766016837913e-02, 2.37137370566165538e-02, 1.77827941003892293e-02, 1.33352143216332406e-02,
    1.00000000000000002e-02, 7.49894209332455791e-03, 5.62341325190349097e-03, 4.21696503428582292e-03,
    3.16227766016837939e-03, 2.37137370566165538e-03, 1.77827941003892275e-03, 1.33352143216332406e-03,
    1.00000000000000002e-03, 7.49894209332455856e-04, 5.62341325190349097e-04, 4.21696503428582237e-04,
    3.16227766016837939e-04, 2.37137370566165538e-04, 1.77827941003892270e-04, 1.33352143216332395e-04};

DEVI void sincos_tab(int idx, float* cs, float* sn) {
    const int pos = idx >> 5, f = idx & 31;
    double a = (double)pos * INVF[f];
    const double TWO_PI = 6.283185307179586476925286766559;
    double k = rint(a / TWO_PI);
    double r = a - k * TWO_PI;
    double r2 = r * r;
    double s = 0.0, c = 0.0, ts = r, tc = 1.0;
#pragma unroll 1
    for (int n = 0; n < 16; ++n) {
        c += tc; s += ts;
        tc = -tc * r2 / (double)((2 * n + 1) * (2 * n + 2));
        ts = -ts * r2 / (double)((2 * n + 2) * (2 * n + 3));
    }
    cs[idx] = (float)c; sn[idx] = (float)s;
}

namespace pg8 {
#define PG8_LAS __attribute__((address_space(3)))
typedef unsigned short bf16_t;
typedef short bf16x8 __attribute__((ext_vector_type(8)));
typedef float f32x4 __attribute__((ext_vector_type(4)));
typedef unsigned u32x4 __attribute__((ext_vector_type(4)));
constexpr int BM = 256, BK = 64, HALF = 128, HTB = HALF * BK * 2  , STAGE_BYTES = 8 * HTB, NXCD = 8, WGM = 8;

__host__ __device__ __forceinline__ int lds_byte(int r, int c) { const int st = (r >> 4) * 2 + (c >> 5), rr = r & 15, cc = c & 31, ob = rr * 64 + cc * 2; return st * 1024 + (ob ^ (((ob >> 9) & 1) << 5)); }
__host__ __device__ __forceinline__ void stage_rc(int b, int& R, int& C) { const int st = b / 1024, sb = b % 1024, swz = sb ^ (((sb >> 9) & 1) << 5); R = (st >> 1) * 16 + swz / 64; C = (st & 1) * 32 + (swz % 64) / 2; }
__host__ __device__ __forceinline__ int perm32(int rho) { const int n = rho >> 4, i = rho & 15; return 8 * (i >> 2) + 4 * n + (i & 3); }

struct Unit { int pm, pn, ord; };
struct Gemm { const bf16_t* A; const bf16_t* Bt; int M, N, K; };

struct StaticOrder {
    int nM, nN, nwg, G, c;
    __host__ __device__ void init(int M, int N, int G_, int c_) { nM = M / BM; nN = N / BM; nwg = nM * nN; G = G_; c = c_; }
    __host__ __device__ bool next(int i, Unit& u) const {
        const long L = (long)i * G + c; if (L >= nwg) return false;
        int wgid = (int)L; { const int q = nwg / NXCD, r = nwg % NXCD, xcd = wgid % NXCD, off = wgid / NXCD; wgid = (xcd < r ? xcd * (q + 1) : r * (q + 1) + (xcd - r) * q) + off; }
        const int nig = WGM * nN, gid = wgid / nig, fm = gid * WGM, gsz = (nM - fm) < WGM ? (nM - fm) : WGM;
        u.pm = fm + ((wgid % nig) % gsz); u.pn = (wgid % nig) / gsz; u.ord = i; return true;
    }
    __device__ __forceinline__ void a_ready(const Unit&) const {}
    __device__ __forceinline__ void done(const Unit&) const {}
};

__device__ __forceinline__ unsigned cvt_pk_bf16(float lo, float hi) { unsigned r; asm volatile("v_cvt_pk_bf16_f32 %0, %1, %2" : "=v"(r) : "v"(lo), "v"(hi)); return r; }
typedef float f32x2 __attribute__((ext_vector_type(2)));
template <class Epi, class Sched, bool ALIGN_EPI = false, bool SP2 = false>
__device__ __forceinline__ void gemm_phase(PG8_LAS unsigned char* lds, const Gemm g, const Sched& S, const Epi& E, int tid_in) {
    int tid_l = tid_in; asm volatile("" : "+v"(tid_l));
    const int tid = tid_l, wid = __builtin_amdgcn_readfirstlane(tid >> 6), lane = tid & 63, wr = wid >> 2, wc = wid & 3, fr = lane & 15, fq = lane >> 4;
    const int K = g.K, nt = K / BK;
    unsigned voffA[2], voffB[2];
#pragma unroll
    for (int i = 0; i < 2; ++i) { int R, C; stage_rc(tid * 16 + i * 8192, R, C); const int Rb = Epi::PERM ? ((R & ~31) + perm32(R & 31)) : R;
        voffA[i] = (unsigned)(R * K + C) * 2u; voffB[i] = (unsigned)(Rb * K + C) * 2u; }
    const size_t kstep = (size_t)(BK * 2);
    const size_t hstep = (size_t)HALF * K * 2;
    const size_t tstep = 2 * hstep;
    const unsigned ldsw = (unsigned)wid * 1024u;
    const int aoff = lds_byte(wr * 64 + fr, fq * 8), boff = lds_byte(wc * 32 + fr, fq * 8);
#define PG8_SA(b, h) (((b) * 2 + (h)) * HTB)
#define PG8_SB(b, h) ((4 + (b) * 2 + (h)) * HTB)
#define PG8_STAGE(bufoff, gbase, voff) do { _Pragma("unroll") for (int _i = 0; _i < 2; ++_i) \
        __builtin_amdgcn_global_load_lds((const unsigned*)((const char*)(gbase) + (voff)[_i]), (PG8_LAS unsigned*)(lds + (bufoff) + ldsw + _i * 8192), 16, 0, 0); } while (0)
#define PG8_LDA(dst, b, h) do { _Pragma("unroll") for (int m = 0; m < 4; ++m) _Pragma("unroll") for (int k = 0; k < 2; ++k) dst[m][k] = *(const PG8_LAS bf16x8*)(lds + PG8_SA(b, h) + aoff + m * 2048 + k * 1024); } while (0)
#define PG8_LDB(dst, b, h) do { _Pragma("unroll") for (int n = 0; n < 2; ++n) _Pragma("unroll") for (int k = 0; k < 2; ++k) dst[n][k] = *(const PG8_LAS bf16x8*)(lds + PG8_SB(b, h) + boff + n * 2048 + k * 1024); } while (0)
#define PG8_MMA(ai, bj, At, Bt) do { __builtin_amdgcn_s_setprio(1); _Pragma("unroll") for (int m = 0; m < 4; ++m) _Pragma("unroll") for (int n = 0; n < 2; ++n) _Pragma("unroll") for (int k = 0; k < 2; ++k) \
        acc[ai][bj][m][n] = __builtin_amdgcn_mfma_f32_16x16x32_bf16(Bt[n][k], At[m][k], acc[ai][bj][m][n], 0, 0, 0); __builtin_amdgcn_s_setprio(0); } while (0)
#define PG8_WAIT_V(n) asm volatile("s_waitcnt vmcnt(" #n ")" ::: "memory")
#define PG8_WAIT_L(n) asm volatile("s_waitcnt lgkmcnt(" #n ")" ::: "memory")
#define PG8_BAR __builtin_amdgcn_s_barrier()
#define PG8_SCHED __builtin_amdgcn_sched_barrier(0)
    Unit cur, nxt; int ui = 0;
    if (!S.next(0, cur)) return;
    f32x4 acc[2][2][4][2];
#pragma unroll
    for (int a = 0; a < 2; ++a)
#pragma unroll
        for (int b = 0; b < 2; ++b)
#pragma unroll
            for (int m = 0; m < 4; ++m)
#pragma unroll
                for (int n = 0; n < 2; ++n) acc[a][b][m][n] = (f32x4){0.f, 0.f, 0.f, 0.f};
    bf16x8 At[4][2], B0[2][2], B1[2][2];
    const char* cA = (const char*)g.A + (size_t)cur.pm * tstep; const char* cB = (const char*)g.Bt + (size_t)cur.pn * tstep;
    S.a_ready(cur);
    if constexpr (SP2) {
        PG8_STAGE(PG8_SB(0, 0), cB, voffB); PG8_STAGE(PG8_SB(0, 1), cB + hstep, voffB); PG8_STAGE(PG8_SA(0, 0), cA, voffA); PG8_STAGE(PG8_SA(0, 1), cA + hstep, voffA);
        if (wr == 1) PG8_BAR;
        PG8_WAIT_V(2); PG8_BAR;
        PG8_STAGE(PG8_SB(1, 0), cB + kstep, voffB); PG8_STAGE(PG8_SA(1, 0), cA + kstep, voffA); PG8_STAGE(PG8_SB(1, 1), cB + hstep + kstep, voffB);
        PG8_WAIT_V(6); PG8_BAR;
    } else {
        PG8_STAGE(PG8_SB(0, 0), cB, voffB); PG8_STAGE(PG8_SA(0, 0), cA, voffA); PG8_STAGE(PG8_SB(0, 1), cB + hstep, voffB); PG8_STAGE(PG8_SA(0, 1), cA + hstep, voffA);
        if (wr == 1) PG8_BAR;
        PG8_WAIT_V(4); PG8_BAR;
        PG8_STAGE(PG8_SB(1, 0), cB + kstep, voffB); PG8_STAGE(PG8_SA(1, 0), cA + kstep, voffA); PG8_STAGE(PG8_SB(1, 1), cB + hstep + kstep, voffB);
        PG8_WAIT_V(6); PG8_BAR;
    }
    for (;;) {
        const bool has_next = S.next(ui + 1, nxt);
        const char* nA = has_next ? (const char*)g.A + (size_t)nxt.pm * tstep : cA; const char* nB = has_next ? (const char*)g.Bt + (size_t)nxt.pn * tstep : cB;
        for (int t = 0; t < nt; t += 2) {
            const bool last = (t == nt - 2);
            const char* a1 = cA + (size_t)(t + 1) * kstep;
            const char* a2 = last ? nA : cA + (size_t)(t + 2) * kstep; const char* b2 = last ? nB : cB + (size_t)(t + 2) * kstep;
            const char* a3 = a2 + kstep; const char* b3 = b2 + kstep;
            if (last && has_next) S.a_ready(nxt);
            if constexpr (SP2) {
            PG8_LDB(B0, 0, 0); PG8_LDB(B1, 0, 1); PG8_SCHED; PG8_LDA(At, 0, 0); PG8_STAGE(PG8_SA(1, 1), a1 + hstep, voffA);
            PG8_WAIT_V(8); PG8_WAIT_L(0); PG8_BAR; PG8_MMA(0, 0, At, B0); PG8_MMA(0, 1, At, B1); PG8_BAR; PG8_SCHED;
            PG8_LDA(At, 0, 1); PG8_STAGE(PG8_SB(0, 0), b2, voffB); PG8_STAGE(PG8_SB(0, 1), b2 + hstep, voffB); PG8_STAGE(PG8_SA(0, 0), a2, voffA);
            PG8_WAIT_V(8); PG8_WAIT_L(0); PG8_BAR; PG8_MMA(1, 0, At, B0); PG8_MMA(1, 1, At, B1); PG8_BAR; PG8_SCHED;
            PG8_LDB(B0, 1, 0); PG8_LDB(B1, 1, 1); PG8_SCHED; PG8_LDA(At, 1, 0); PG8_STAGE(PG8_SA(0, 1), a2 + hstep, voffA);
            PG8_WAIT_V(8); PG8_WAIT_L(0); PG8_BAR; PG8_MMA(0, 0, At, B0); PG8_MMA(0, 1, At, B1); PG8_BAR; PG8_SCHED;
            PG8_LDA(At, 1, 1); PG8_STAGE(PG8_SB(1, 0), b3, voffB); PG8_STAGE(PG8_SB(1, 1), b3 + hstep, voffB); PG8_STAGE(PG8_SA(1, 0), a3, voffA);
            PG8_WAIT_V(8); PG8_WAIT_L(0); PG8_BAR; PG8_MMA(1, 0, At, B0); PG8_MMA(1, 1, At, B1); PG8_BAR; PG8_SCHED;
            } else {
            PG8_LDB(B0, 0, 0); PG8_SCHED; PG8_LDA(At, 0, 0); PG8_STAGE(PG8_SA(1, 1), a1 + hstep, voffA);
            PG8_WAIT_L(8); PG8_BAR; PG8_WAIT_L(0); PG8_MMA(0, 0, At, B0); PG8_BAR; PG8_SCHED;
            PG8_LDB(B1, 0, 1); PG8_STAGE(PG8_SB(0, 0), b2, voffB);
            PG8_BAR; PG8_WAIT_L(0); PG8_MMA(0, 1, At, B1); PG8_BAR;
            PG8_LDA(At, 0, 1); PG8_STAGE(PG8_SA(0, 0), a2, voffA);
            PG8_BAR; PG8_WAIT_L(0); PG8_MMA(1, 0, At, B0); PG8_BAR; PG8_SCHED;
            PG8_STAGE(PG8_SB(0, 1), b2 + hstep, voffB);
            PG8_WAIT_V(6); PG8_BAR; PG8_MMA(1, 1, At, B1); PG8_BAR;
            PG8_LDB(B0, 1, 0); PG8_SCHED; PG8_LDA(At, 1, 0); PG8_STAGE(PG8_SA(0, 1), a2 + hstep, voffA);
            PG8_WAIT_L(8); PG8_BAR; PG8_WAIT_L(0); PG8_MMA(0, 0, At, B0); PG8_BAR; PG8_SCHED;
            PG8_LDB(B1, 1, 1); PG8_STAGE(PG8_SB(1, 0), b3, voffB);
            PG8_BAR; PG8_WAIT_L(0); PG8_MMA(0, 1, At, B1); PG8_BAR;
            PG8_LDA(At, 1, 1); PG8_STAGE(PG8_SA(1, 0), a3, voffA);
            PG8_BAR; PG8_WAIT_L(0); PG8_MMA(1, 0, At, B0); PG8_BAR; PG8_SCHED;
            PG8_STAGE(PG8_SB(1, 1), b3 + hstep, voffB);
            PG8_WAIT_V(6); PG8_BAR; PG8_MMA(1, 1, At, B1); PG8_BAR;
            }
        }
        if constexpr (ALIGN_EPI) { if (wr == 0) PG8_BAR; }
        if constexpr (!Epi::AFTER_DRAIN) { E(acc, cur, wr, wc, fr, fq); S.done(cur); }
        if (!has_next) break;
#pragma unroll
        for (int a = 0; a < 2; ++a)
#pragma unroll
            for (int b = 0; b < 2; ++b)
#pragma unroll
                for (int m = 0; m < 4; ++m)
#pragma unroll
                    for (int n = 0; n < 2; ++n) acc[a][b][m][n] = (f32x4){0.f, 0.f, 0.f, 0.f};
        cur = nxt; cA = nA; cB = nB; ++ui;
        if constexpr (ALIGN_EPI) { if (wr == 1) PG8_BAR; }
    }
    PG8_WAIT_V(0);
    if constexpr (!ALIGN_EPI) { if (wr == 0) PG8_BAR; }
    PG8_BAR;
    if constexpr (Epi::AFTER_DRAIN) { E.fused(acc, cur, wr, wc, fr, fq, lds, wid, lane); S.done(cur); }
#undef PG8_SA
#undef PG8_SB
#undef PG8_STAGE
#undef PG8_LDA
#undef PG8_LDB
#undef PG8_MMA
#undef PG8_WAIT_V
#undef PG8_WAIT_L
#undef PG8_BAR
#undef PG8_SCHED
}
}

#include <hip/hip_bf16.h>
#include <cmath>
namespace attn_body {
using bf16=__hip_bfloat16;
using bf16x8=__attribute__((ext_vector_type(8)))short;
using s16x4=__attribute__((ext_vector_type(4)))short;
using f32x16=__attribute__((ext_vector_type(16)))float;
using u32x4=__attribute__((ext_vector_type(4)))unsigned;
typedef float f32x4 __attribute__((ext_vector_type(4)));
constexpr int SEQ=8192,D=64;
constexpr int NW=8,QBLK=32,QB=QBLK*NW,KVBLK=64,NQB=SEQ/QB;
__device__ __forceinline__ int crow(int r,int hi){return (r&3)+8*(r>>2)+4*hi;}
#define SBAR() __builtin_amdgcn_sched_barrier(0)
__device__ __forceinline__ void cmask(f32x16&p0,f32x16&p1,int jb,int qrel,int hi){
  const float NEG=-INFINITY; int kb=64*jb+4*hi;
  #pragma unroll
  for(int r=0;r<16;++r){int kv=kb+(r&3)+8*(r>>2); if(kv>qrel)p0[r]=NEG; if(kv+32>qrel)p1[r]=NEG;}
}

__device__ __forceinline__ void wmask(f32x16&p0,f32x16&p1,int k0,int qrel,int hi){
  const float NEG=-INFINITY; const int kb=k0+4*hi;
  #pragma unroll
  for(int r=0;r<16;++r){const int kv=kb+(r&3)+8*(r>>2); if((unsigned)(qrel-kv)>=128u)p0[r]=NEG; if((unsigned)(qrel-kv-32)>=128u)p1[r]=NEG;}
}
constexpr int NSLOT=3, SLOTB=8192;
constexpr int LDS_K=0, LDS_V=NSLOT*SLOTB, LDS_WS=2*NSLOT*SLOTB, LDS_OST=LDS_WS+NW*64*4, LDS_BYTES=LDS_OST+NW*4096;
constexpr float C2=0.125f*1.4426950408889634f;
__device__ __forceinline__ void glds16(const void*gsrc,unsigned lds_dst){unsigned keep;
  asm volatile("s_mov_b32 %0, m0\n\ts_mov_b32 m0, %2\n\ts_nop 0\n\tglobal_load_lds_dwordx4 %1, off\n\ts_mov_b32 m0, %0":"=&s"(keep):"v"(gsrc),"s"(lds_dst):"memory");}
__device__ __forceinline__ float max3f(float a,float b,float c){float r;asm("v_max3_f32 %0, %1, %2, %3":"=v"(r):"v"(a),"v"(b),"v"(c));return r;}
__device__ __forceinline__ float max2f(float a,float b){float r;asm("v_max_f32_e32 %0, %1, %2":"=v"(r):"v"(a),"v"(b));return r;}
__device__ __forceinline__ float fadd_s(float a,float b){float r;asm("v_add_f32_e32 %0, %1, %2":"=v"(r):"v"(a),"v"(b));return r;}
__device__ __forceinline__ float fsub_s(float a,float b){float r;asm("v_sub_f32_e32 %0, %1, %2":"=v"(r):"v"(a),"v"(b));return r;}
typedef float f32x2_t __attribute__((ext_vector_type(2))); typedef __bf16 bf16x2_t __attribute__((ext_vector_type(2)));
__device__ __forceinline__ unsigned cvtpk_s(float lo,float hi){f32x2_t v={lo,hi};bf16x2_t b=__builtin_convertvector(v,bf16x2_t);return __builtin_bit_cast(unsigned,b);}
#define WAIT_BAR(N) asm volatile("s_waitcnt vmcnt(" #N ") lgkmcnt(0)\n\ts_barrier":::"memory")

__device__ __forceinline__ void qkt(f32x16&p0,f32x16&p1,const char*Kslot,const bf16x8*qr,const f32x16&negm,int r32,int hi){
  const char*kb=Kslot+hi*1024+r32*16;
  #pragma unroll
  for(int d0=0;d0<4;++d0){
    const bf16x8 b0=*reinterpret_cast<const bf16x8*>(kb+d0*2048);
    const bf16x8 b1=*reinterpret_cast<const bf16x8*>(kb+d0*2048+512);
    if(d0==0){p0=__builtin_amdgcn_mfma_f32_32x32x16_bf16(b0,qr[0],negm,0,0,0);p1=__builtin_amdgcn_mfma_f32_32x32x16_bf16(b1,qr[0],negm,0,0,0);}
    else{p0=__builtin_amdgcn_mfma_f32_32x32x16_bf16(b0,qr[d0],p0,0,0,0);p1=__builtin_amdgcn_mfma_f32_32x32x16_bf16(b1,qr[d0],p1,0,0,0);}}
}
typedef __attribute__((address_space(3))) const char* lds_cptr;
typedef short v4i16_t __attribute__((ext_vector_type(4)));
__device__ __forceinline__ void kload8(bf16x8*kf,lds_cptr kp){
  kf[0]=*(const __attribute__((address_space(3))) bf16x8*)(kp);      kf[1]=*(const __attribute__((address_space(3))) bf16x8*)(kp+512);
  kf[2]=*(const __attribute__((address_space(3))) bf16x8*)(kp+2048); kf[3]=*(const __attribute__((address_space(3))) bf16x8*)(kp+2560);
  kf[4]=*(const __attribute__((address_space(3))) bf16x8*)(kp+4096); kf[5]=*(const __attribute__((address_space(3))) bf16x8*)(kp+4608);
  kf[6]=*(const __attribute__((address_space(3))) bf16x8*)(kp+6144); kf[7]=*(const __attribute__((address_space(3))) bf16x8*)(kp+6656);
}
__device__ __forceinline__ void kload2(bf16x8*kf,lds_cptr kp,int j){ kf[2*j]=*(const __attribute__((address_space(3))) bf16x8*)(kp+j*2048); kf[2*j+1]=*(const __attribute__((address_space(3))) bf16x8*)(kp+j*2048+512); }
__device__ __forceinline__ s16x4 vtr(lds_cptr p){ return __builtin_bit_cast(s16x4,__builtin_amdgcn_ds_read_tr16_b64_v4i16((__attribute__((address_space(3))) v4i16_t*)p)); }
__device__ __forceinline__ float rowmax(const f32x16&p0,const f32x16&p1){
  float a=max3f(p0[0],p0[1],p1[0]),b=max3f(p0[2],p0[3],p1[1]);a=max3f(a,p1[2],p1[3]);
  #pragma unroll
  for(int r=4;r<16;r+=4){a=max3f(a,p0[r],p0[r+1]);b=max3f(b,p0[r+2],p0[r+3]);a=max3f(a,p1[r],p1[r+1]);b=max3f(b,p1[r+2],p1[r+3]);}
  const float m=max2f(a,b);
  auto rr=__builtin_amdgcn_permlane32_swap(__float_as_uint(m),__float_as_uint(m),false,false);
  return max2f(__uint_as_float(rr[0]),__uint_as_float(rr[1]));
}
__device__ __forceinline__ void pv(f32x16*o,int vb,bf16x8 pa0,bf16x8 pa1,bf16x8 pa2,bf16x8 pa3){
  #pragma unroll
  for(int d0=0;d0<2;++d0){s16x4 lo[4],hi[4];
    #pragma unroll
    for(int ks=0;ks<4;++ks){
      asm volatile("ds_read_b64_tr_b16 %0,%1 offset:%c2":"=&v"(lo[ks]):"v"(vb),"i"(d0*4096+ks*1024):"memory");
      asm volatile("ds_read_b64_tr_b16 %0,%1 offset:%c2":"=&v"(hi[ks]):"v"(vb),"i"(d0*4096+ks*1024+512):"memory");}
    asm volatile("s_waitcnt lgkmcnt(0)":::"memory");SBAR();
    #define PK(k) (bf16x8){lo[k][0],lo[k][1],lo[k][2],lo[k][3],hi[k][0],hi[k][1],hi[k][2],hi[k][3]}
    o[d0]=__builtin_amdgcn_mfma_f32_32x32x16_bf16(pa0,PK(0),o[d0],0,0,0);
    o[d0]=__builtin_amdgcn_mfma_f32_32x32x16_bf16(pa1,PK(1),o[d0],0,0,0);
    o[d0]=__builtin_amdgcn_mfma_f32_32x32x16_bf16(pa2,PK(2),o[d0],0,0,0);
    o[d0]=__builtin_amdgcn_mfma_f32_32x32x16_bf16(pa3,PK(3),o[d0],0,0,0);
    #undef PK
  }
}

#ifndef ATTN_STORE16
#define ATTN_STORE16(p,v) (*(u32x4*)(p)=(v))
#endif
template<int THRL,int MODE,int QP,int KP> __device__ __forceinline__ void attn_unit(int b,int qb,int qcol,int kcol,const bf16*Q,const bf16*__restrict__ K,const bf16*__restrict__ V,bf16*O,const __attribute__((address_space(3))) float* kmean,float sink2,char*shm,int tid_in){
  int tid_l=tid_in; asm volatile("":"+v"(tid_l));
  const int tid=tid_l,lane=tid&63,r32=lane&31,hi=lane>>5; const int wid=__builtin_amdgcn_readfirstlane(tid>>6);
  const long rowbase=(long)b*SEQ; const int q0=qb*QB;
  const int T0=(MODE==1&&qb>0)?4*qb-2:0;
  const bf16*Qw=Q+(rowbase+q0+wid*QBLK)*QP+qcol;
  const bf16*Kh=K+(rowbase+T0*KVBLK)*KP+kcol,*Vh=V+(rowbase+T0*KVBLK)*KP+kcol;
  const unsigned lds0=(unsigned)(uintptr_t)shm;
  float*wsf=(float*)(shm+LDS_WS)+wid*64;
  const bf16*ksrc=Kh+(long)lane*KP+wid*8;
  const bf16*vsrc=Vh+(long)(16*(wid&3)+(lane>>2))*KP+(wid>>2)*32+(lane&3)*8;
  const unsigned kdst=lds0+LDS_K+wid*1024, vdst=lds0+LDS_V+wid*1024;
  #define DMA_K(t,slot) glds16(ksrc+(long)(t)*KVBLK*KP,(unsigned)__builtin_amdgcn_readfirstlane(kdst+(slot)))
  #define DMA_V(t,slot) glds16(vsrc+(long)(t)*KVBLK*KP,(unsigned)__builtin_amdgcn_readfirstlane(vdst+(slot)))
  const int vb0=(int)(lds0+LDS_V)+((lane>>4)&1)*32+(lane&3)*8+(4*hi+((lane&15)>>2))*64;
  const char*Kbase=shm+LDS_K; bf16x8 kf[8];
  const lds_cptr shm3=(lds_cptr)shm; const lds_cptr kp0=shm3+LDS_K+hi*1024+r32*16; const lds_cptr vp0=shm3+LDS_V+((lane>>4)&1)*32+(lane&3)*8+(4*hi+((lane&15)>>2))*64;
  const int NT=(MODE==1)?((qb>0)?6:4):(q0+QB)/KVBLK;
  DMA_K(0,0);DMA_V(0,0);DMA_K(1,SLOTB);
  bf16x8 qr[4];
  #pragma unroll
  for(int d0=0;d0<4;++d0)qr[d0]=*reinterpret_cast<const bf16x8*>(&Qw[(long)r32*QP+d0*16+hi*8]);
  float zl_=0.f; asm volatile("":"+v"(zl_));
  float mhat=0.f,l_reg=0.f;f32x16 o[2],negm;
  #pragma unroll
  for(int r_=0;r_<16;++r_){o[0][r_]=zl_;o[1][r_]=zl_;negm[r_]=zl_;}
  asm volatile("":"+v"(negm));
  const int qrel=wid*QBLK+r32;
  unsigned selmask=0u;
  if(MODE==0){ float v1=-INFINITY,v2=-INFINITY,v3=-INFINITY; int i1=-1,i2=-1,i3=-1;
    for(int j=0;j<qb;++j){ const __attribute__((address_space(3))) float*km=kmean+j*64+hi*8; float g=0.f;
      #pragma unroll
      for(int d0=0;d0<4;++d0){ const f32x4 ka=*(const __attribute__((address_space(3))) f32x4*)(km+d0*16), kb=*(const __attribute__((address_space(3))) f32x4*)(km+d0*16+4);
        #pragma unroll
        for(int e=0;e<4;++e){ g=__builtin_fmaf(__uint_as_float(((unsigned)(unsigned short)qr[d0][e])<<16),ka[e],g); g=__builtin_fmaf(__uint_as_float(((unsigned)(unsigned short)qr[d0][4+e])<<16),kb[e],g);} }
      { auto rr_=__builtin_amdgcn_permlane32_swap(__float_as_uint(g),__float_as_uint(g),false,false); g=__uint_as_float(rr_[0])+__uint_as_float(rr_[1]); }
      if(g>v1){v3=v2;i3=i2;v2=v1;i2=i1;v1=g;i1=j;} else if(g>v2){v3=v2;i3=i2;v2=g;i2=j;} else if(g>v3){v3=g;i3=j;} }
    if(i1>=0)selmask|=1u<<i1; if(i2>=0)selmask|=1u<<i2; if(i3>=0)selmask|=1u<<i3; }
  const int wk0=(T0-4*qb)*KVBLK;
  #define BMASK(P0,P1,t) do{ if(!((selmask>>((t)>>2))&1u)){ _Pragma("unroll") for(int r_=0;r_<16;++r_){P0[r_]=-INFINITY;P1[r_]=-INFINITY;} } }while(0)
  #define CMASK(P0,P1,t) do{ if(MODE==1){ wmask(P0,P1,wk0+64*(t),qrel,hi); } else { int jb_=(t)-(NT-4); if(jb_>=0)cmask(P0,P1,jb_,qrel,hi); else BMASK(P0,P1,t); } }while(0)
  bool resc=false;
  #define START(P0,P1) do{ const float rm=rowmax(P0,P1); resc=false; \
    { const float dl=__builtin_fmaxf(rm,-100.f); mhat=fadd_s(mhat,dl); \
      _Pragma("unroll") for(int r=0;r<16;++r){P0[r]=fsub_s(P0[r],dl);P1[r]=fsub_s(P1[r],dl);} \
      _Pragma("unroll") for(int r=0;r<16;++r)negm[r]=-mhat; asm volatile("":"+v"(negm)); } \
    _Pragma("unroll") for(int r=0;r<16;++r)P0[r]=__builtin_amdgcn_exp2f(P0[r]); }while(0)
  #define RESC() do{ if(resc){ asm volatile("s_waitcnt lgkmcnt(0)":::"memory"); \
      _Pragma("unroll") for(int d_=0;d_<2;++d_) _Pragma("unroll") for(int r=0;r<16;++r)o[d_][r]*=wsf[crow(r,hi)]; } }while(0)
  f32x16 pA0,pA1,pB0,pB1;
  int sl_prev=0,sl_cur=0,sl_next=SLOTB;
  #define ROT() do{sl_prev=sl_cur;sl_cur=sl_next;sl_next=(sl_next==(NSLOT-1)*SLOTB)?0:sl_next+SLOTB;}while(0)
  DMA_K(2,2*SLOTB);
  WAIT_BAR(3);
  qkt(pA0,pA1,Kbase,qr,negm,r32,hi);asm volatile("s_nop 15\n\ts_nop 7":"+v"(pA0),"+v"(pA1));CMASK(pA0,pA1,0);
  START(pA0,pA1);
  _Pragma("unroll") for(int r=0;r<16;++r)pA1[r]=__builtin_amdgcn_exp2f(pA1[r]);
  WAIT_BAR(0);
  DMA_K(3,0);DMA_V(1,SLOTB);
  ROT();
  kload8(kf,kp0+sl_cur);
  WAIT_BAR(2);
  s16x4 vlo[8],vhi[8]; u32x4 pw0,pw1,pw2,pw3;
  #define PKW(P,B) cvtpk_s(P[B],P[B+1])
  #define PAF(k) __builtin_bit_cast(bf16x8,pw##k)
  #define VFR(i) (bf16x8){vlo[i][0],vlo[i][1],vlo[i][2],vlo[i][3],vhi[i][0],vhi[i][1],vhi[i][2],vhi[i][3]}
  #define PIN(x) asm volatile("":"+v"(x))
  #define MX3(a,b,c) __builtin_fmaxf(__builtin_fmaxf((a),(b)),(c))
  #define GAPA(MF,A0,A1,A2,A3,W0,W1,PW) do{ MF; sacc+=A0; sacc+=A1; sacc+=A2; sacc+=A3; PIN(sacc); W0; W1; PIN(PW); SBAR(); }while(0)
  #define EX(v) __builtin_amdgcn_exp2f(v)
  #define GAPB(MF,X,B) do{ MF; X[B]=EX(X[B]); X[B+1]=EX(X[B+1]); X[B+2]=EX(X[B+2]); X[B+3]=EX(X[B+3]); PIN(X); SBAR(); }while(0)
  #define VRD(i) do{ vlo[i]=vtr(vp_+(((i)>>2)*4096+((i)&3)*1024)); vhi[i]=vtr(vp_+(((i)>>2)*4096+((i)&3)*1024+512)); }while(0)
  #define KRD(G,j) do{ if(G){ kload2(kf,kp0+sl_next,j); SBAR(); } }while(0)
  #define STEP(C0,C1,P0,P1,t,GK,GV,GL) do{ SBAR(); \
    const lds_cptr vp_=vp0+sl_prev; \
    VRD(0); SBAR(); float sacc=(P0[0]+P0[1]); \
    GAPA(C0=__builtin_amdgcn_mfma_f32_32x32x16_bf16(kf[0],qr[0],negm,0,0,0), P0[2],P0[3],P0[4],P0[5],     pw0[0]=PKW(P0,0), pw0[1]=PKW(P0,2), pw0); \
    VRD(4); SBAR(); GAPA(C1=__builtin_amdgcn_mfma_f32_32x32x16_bf16(kf[1],qr[0],negm,0,0,0), P0[6],P0[7],P0[8],P0[9],     pw0[2]=PKW(P0,4), pw0[3]=PKW(P0,6), pw0); \
    VRD(1); SBAR(); GAPA(C0=__builtin_amdgcn_mfma_f32_32x32x16_bf16(kf[2],qr[1],C0,0,0,0),   P0[10],P0[11],P0[12],P0[13], pw1[0]=PKW(P0,8), pw1[1]=PKW(P0,10), pw1); \
    VRD(5); SBAR(); GAPA(C1=__builtin_amdgcn_mfma_f32_32x32x16_bf16(kf[3],qr[1],C1,0,0,0),   P0[14],P0[15],P1[0],P1[1],   pw1[2]=PKW(P0,12),pw1[3]=PKW(P0,14), pw1); \
    VRD(2); SBAR(); GAPA(C0=__builtin_amdgcn_mfma_f32_32x32x16_bf16(kf[4],qr[2],C0,0,0,0),   P1[2],P1[3],P1[4],P1[5],     pw2[0]=PKW(P1,0), pw2[1]=PKW(P1,2), pw2); \
    VRD(6); SBAR(); GAPA(C1=__builtin_amdgcn_mfma_f32_32x32x16_bf16(kf[5],qr[2],C1,0,0,0),   P1[6],P1[7],P1[8],P1[9],     pw2[2]=PKW(P1,4), pw2[3]=PKW(P1,6), pw2); \
    VRD(3); SBAR(); GAPA(C0=__builtin_amdgcn_mfma_f32_32x32x16_bf16(kf[6],qr[3],C0,0,0,0),   P1[10],P1[11],P1[12],P1[13], pw3[0]=PKW(P1,8), pw3[1]=PKW(P1,10), pw3); \
    VRD(7); SBAR(); GAPA(C1=__builtin_amdgcn_mfma_f32_32x32x16_bf16(kf[7],qr[3],C1,0,0,0),   P1[14],P1[15],0.f,0.f,       pw3[2]=PKW(P1,12),pw3[3]=PKW(P1,14), pw3); \
    l_reg+=sacc; \
    if(GK){DMA_K((t)+3,sl_cur);} if(GV){DMA_V((t)+1,sl_next);} \
    CMASK(C0,C1,t); \
    { float a=MX3(C0[0],C0[1],C1[0]),b=MX3(C0[2],C0[3],C1[1]); a=MX3(a,C1[2],C1[3]); \
      _Pragma("unroll") for(int r=4;r<16;r+=4){a=MX3(a,C0[r],C0[r+1]);b=MX3(b,C0[r+2],C0[r+3]);a=MX3(a,C1[r],C1[r+1]);b=MX3(b,C1[r+2],C1[r+3]);} \
      float rm=__builtin_fmaxf(a,b); { auto rr=__builtin_amdgcn_permlane32_swap(__float_as_uint(rm),__float_as_uint(rm),false,false); rm=__builtin_fmaxf(__uint_as_float(rr[0]),__uint_as_float(rr[1])); } \
      resc=false; \
      if(__builtin_expect(__any(rm>(float)THRL),0)){ const float dl=__builtin_fmaxf(rm,0.f); mhat+=dl; \
        _Pragma("unroll") for(int r=0;r<16;++r){C0[r]-=dl;C1[r]-=dl;} \
        _Pragma("unroll") for(int r=0;r<16;++r)negm[r]=-mhat; asm volatile("":"+v"(negm)); \
        const float f=__builtin_amdgcn_exp2f(-dl); l_reg*=f; if(hi==0)wsf[r32]=f; resc=true; } } \
    SBAR(); \
    GAPB(o[0]=__builtin_amdgcn_mfma_f32_32x32x16_bf16(PAF(0),VFR(0),o[0],0,0,0), C0,0); \
    GAPB(o[1]=__builtin_amdgcn_mfma_f32_32x32x16_bf16(PAF(0),VFR(4),o[1],0,0,0), C0,4); \
    KRD(GL,0); GAPB(o[0]=__builtin_amdgcn_mfma_f32_32x32x16_bf16(PAF(1),VFR(1),o[0],0,0,0), C0,8); \
    KRD(GL,1); GAPB(o[1]=__builtin_amdgcn_mfma_f32_32x32x16_bf16(PAF(1),VFR(5),o[1],0,0,0), C0,12); \
    KRD(GL,2); GAPB(o[0]=__builtin_amdgcn_mfma_f32_32x32x16_bf16(PAF(2),VFR(2),o[0],0,0,0), C1,0); \
    KRD(GL,3); GAPB(o[1]=__builtin_amdgcn_mfma_f32_32x32x16_bf16(PAF(2),VFR(6),o[1],0,0,0), C1,4); \
    GAPB(o[0]=__builtin_amdgcn_mfma_f32_32x32x16_bf16(PAF(3),VFR(3),o[0],0,0,0), C1,8); \
    GAPB(o[1]=__builtin_amdgcn_mfma_f32_32x32x16_bf16(PAF(3),VFR(7),o[1],0,0,0), C1,12); \
    }while(0)
  int t=1;
  #undef CMASK
  #define CMASK(P0,P1,t) do{ if(MODE==0)BMASK(P0,P1,t); }while(0)
  for(;t+5<NT;t+=2){
    STEP(pB0,pB1,pA0,pA1,t,true,true,true);     WAIT_BAR(2); RESC(); ROT();
    STEP(pA0,pA1,pB0,pB1,t+1,true,true,true);   WAIT_BAR(2); RESC(); ROT();
  }
  #undef CMASK
  #define CMASK(P0,P1,t) do{ if(MODE==1){ wmask(P0,P1,wk0+64*(t),qrel,hi); } else { int jb_=(t)-(NT-4); if(jb_>=0)cmask(P0,P1,jb_,qrel,hi); else BMASK(P0,P1,t); } }while(0)
  #define ENDW(tt) do{ if((tt)+3<NT){WAIT_BAR(2);} else if((tt)+2<NT){WAIT_BAR(1);} else {WAIT_BAR(0);} }while(0)
  for(;t+1<NT;t+=2){
    STEP(pB0,pB1,pA0,pA1,t,(t+3<NT),(t+1<NT),(t+1<NT));       ENDW(t);   RESC(); ROT();
    STEP(pA0,pA1,pB0,pB1,t+1,(t+4<NT),(t+2<NT),(t+2<NT));     ENDW(t+1); RESC(); ROT();
  }
  STEP(pB0,pB1,pA0,pA1,NT-1,false,false,false); RESC();
  { float sacc=pB0[0]+pB0[1]; _Pragma("unroll") for(int r=2;r<16;++r)sacc+=pB0[r]; _Pragma("unroll") for(int r=0;r<16;++r)sacc+=pB1[r]; l_reg+=sacc;
    pw0=(u32x4){PKW(pB0,0),PKW(pB0,2),PKW(pB0,4),PKW(pB0,6)};pw1=(u32x4){PKW(pB0,8),PKW(pB0,10),PKW(pB0,12),PKW(pB0,14)};pw2=(u32x4){PKW(pB1,0),PKW(pB1,2),PKW(pB1,4),PKW(pB1,6)};pw3=(u32x4){PKW(pB1,8),PKW(pB1,10),PKW(pB1,12),PKW(pB1,14)};
    SBAR(); pv(o,vb0+sl_cur,PAF(0),PAF(1),PAF(2),PAF(3)); }
  #undef PKW
  #undef PAF
  #undef VFR
  #undef PIN
  #undef MX3
  #undef GAPA
  #undef GAPB
  #undef EX
  #undef VRD
  #undef KRD
  #undef STEP
  #undef ENDW
  {auto rr=__builtin_amdgcn_permlane32_swap(__float_as_uint(l_reg),__float_as_uint(l_reg),false,false);l_reg=__uint_as_float(rr[0])+__uint_as_float(rr[1]);}
  if(MODE==1)l_reg+=__builtin_amdgcn_exp2f(sink2-mhat);
  if(hi==0)wsf[32+r32]=l_reg;asm volatile("s_waitcnt lgkmcnt(0)":::"memory");
  float rli[16];
  #pragma unroll
  for(int r=0;r<16;++r)rli[r]=__builtin_amdgcn_rcpf(wsf[32+crow(r,hi)]);
  bf16*Ow=O+(rowbase+q0+wid*QBLK)*QP+qcol;
  { bf16*stg=(bf16*)(shm+LDS_OST)+wid*2048;
    #pragma unroll
    for(int r=0;r<16;++r){const int orow=crow(r,hi);
      #pragma unroll
      for(int d0=0;d0<2;++d0)stg[orow*64+d0*32+r32]=__float2bfloat16(o[d0][r]*rli[r]);}
    asm volatile("s_waitcnt lgkmcnt(0)":::"memory");
    #pragma unroll
    for(int i=0;i<4;++i){const int row=i*8+(lane>>3),ch=lane&7; const u32x4 v=*(const u32x4*)(stg+row*64+ch*8); ATTN_STORE16(Ow+(long)row*QP+ch*8,v);} }
  asm volatile("s_waitcnt lgkmcnt(0)\n\ts_barrier":::"memory");
  #undef DMA_K
  #undef DMA_V
  #undef CMASK
  #undef BMASK
  #undef START
  #undef RESC
  #undef ROT
}
constexpr int ATTN_LDS_BYTES=LDS_BYTES;
#undef SBAR
#undef WAIT_BAR
}

#include <hip/hip_cooperative_groups.h>
namespace cg = cooperative_groups;
#define LAS __attribute__((address_space(3)))
typedef pg8::f32x4 f32x4;
typedef unsigned u32x4 __attribute__((ext_vector_type(4)));
typedef unsigned u32x2 __attribute__((ext_vector_type(2)));
typedef float f32x2_t __attribute__((ext_vector_type(2))); typedef __bf16 bf16x2_t __attribute__((ext_vector_type(2)));
DEVI unsigned pk2(float lo, float hi) { f32x2_t v = {lo, hi}; bf16x2_t b = __builtin_convertvector(v, bf16x2_t); return __builtin_bit_cast(unsigned, b); }
DEVI float bflo(unsigned u) { return __uint_as_float(u << 16); }
DEVI float bfhi(unsigned u) { return __uint_as_float(u & 0xffff0000u); }

DEVI int mk_lane_id() { int l; asm volatile("v_mbcnt_lo_u32_b32 %0, -1, 0\n\tv_mbcnt_hi_u32_b32 %0, -1, %0" : "=v"(l)); return l; }
DEVI float bperm_xor(float v, int lane, int mask) { return __int_as_float(__builtin_amdgcn_ds_bpermute((lane ^ mask) << 2, __float_as_int(v))); }
DEVI float wave_sum_l(float v, int lane) {
#pragma unroll
    for (int o = 1; o < 64; o <<= 1) v += bperm_xor(v, lane, o);
    return v;
}
constexpr size_t WO_IN = 0, WO_GATE = 6815744, WO_BR = WO_GATE + 6 * MiB, WO_OUT = WO_BR + 3 * MiB, WO_FF1 = WO_OUT + 2 * MiB, WO_FF2 = WO_FF1 + 8 * MiB;
static_assert(WO_FF2 + 8 * MiB <= 34 * MiB, "W region");
constexpr int NPERM = 3328;

DEVI int win_src_col(int np) {
    int s0, nat, rope;
    if (np < 512) { s0 = 0; nat = 0; rope = 1; }
    else if (np < 576) { s0 = 512; nat = 512; rope = 1; }
    else if (np < 640) { s0 = 576; nat = 576; rope = 0; }
    else if (np < 896) { s0 = 640; nat = 640; rope = 1; }
    else if (np < 960) { s0 = 896; nat = 896; rope = 1; }
    else if (np < 1472) { s0 = 960; nat = 964; rope = 1; }
    else if (np < 1600) { s0 = 1472; nat = 1476; rope = 1; }
    else if (np < 1728) { s0 = 1600; nat = 1604; rope = 0; }
    else if (np < 2240) { s0 = 1728; nat = 1732; rope = 1; }
    else if (np < 2752) { s0 = 2240; nat = 2244; rope = 1; }
    else if (np < 3264) { s0 = 2752; nat = 2756; rope = 0; }
    else { const int r = np - 3264; return (r < 4) ? 960 + r : -1; }
    const int r = np - s0;
    if (!rope) return nat + r;
    const int hb = r >> 6, w = r & 63;
    return nat + 64 * hb + (w >> 1) + 32 * (w & 1);
}
struct MapWin { DEVI int operator()(int n) const { return win_src_col(n); } };
struct MapOff { int off; DEVI int operator()(int n) const { return off + n; } };

struct TrItem { const float* W; bf16_t* WT; int ldw, K, k0, n0, sc; };
DEVI void tr_load(const TrItem& t, float (&v)[32], int lane) {
    const float* p = t.W + (size_t)(t.k0 + (lane >> 5)) * t.ldw + (t.sc >= 0 ? t.sc : 0);
    const unsigned msk = (t.sc >= 0) ? 0xffffffffu : 0u;
#pragma unroll
    for (int i = 0; i < 32; ++i) v[i] = __uint_as_float(__float_as_uint(p[(size_t)(2 * i) * t.ldw]) & msk);
}
DEVI void tr_store(const TrItem& t, const float (&v)[32], LAS float* scr, int lane) {
#pragma unroll
    for (int i = 0; i < 32; ++i) scr[(2 * i + (lane >> 5)) * 33 + (lane & 31)] = v[i];
    asm volatile("s_waitcnt lgkmcnt(0)" ::: "memory");
    const int c = lane & 7;
#pragma unroll
    for (int j = 0; j < 4; ++j) {
        const int n = (lane >> 3) + 8 * j; const LAS float* s = scr + (8 * c) * 33 + n;
        u32x4 o; o.x = pk2(s[0 * 33], s[1 * 33]); o.y = pk2(s[2 * 33], s[3 * 33]); o.z = pk2(s[4 * 33], s[5 * 33]); o.w = pk2(s[6 * 33], s[7 * 33]);
        *(u32x4*)(t.WT + (size_t)(t.n0 + n) * t.K + t.k0 + 8 * c) = o;
    }
    asm volatile("s_waitcnt lgkmcnt(0)" ::: "memory");
}

constexpr int RSTD_TAB_OFF = 131072;
template <class Sched>
DEVI void fill_rstd_table(const Sched& S, const float* SSQ, LAS unsigned char* lds, int tid) {
    LAS float* tab = (LAS float*)(lds + RSTD_TAB_OFF);
#pragma unroll
    for (int k = 0; k < 2; ++k) {
        const int i = (tid >> 8) + 2 * k; pg8::Unit u;
        if (S.next(i, u)) tab[i * 256 + (tid & 255)] = rstd_of(SSQ, u.pm * 256 + (tid & 255));
    }
    asm volatile("s_waitcnt lgkmcnt(0)" ::: "memory"); __builtin_amdgcn_s_barrier();
}
struct EpiProjMK {
    static constexpr bool PERM = true, AFTER_DRAIN = false;
    const LAS float* tab; unsigned char* ws; const float* COS; const float* SIN;
    DEVI void operator()(const f32x4 (&acc)[2][2][4][2], const pg8::Unit& u, int wr, int wc, int fr, int fq) const {
        const int row0 = u.pm * 256 + wr * 64 + fr;
        const int j = 4 * (wc & 1) + fq;
#pragma unroll
        for (int ai = 0; ai < 2; ++ai) {
            f32x4 c4[4], s4[4]; float rs[4];
#pragma unroll
            for (int m = 0; m < 4; ++m) {
                const int row = row0 + ai * 128 + m * 16, pos = row & (SEQ - 1);
                c4[m] = *(const f32x4*)(COS + pos * 32 + 4 * j); s4[m] = *(const f32x4*)(SIN + pos * 32 + 4 * j);
                rs[m] = tab[u.ord * 256 + wr * 64 + fr + ai * 128 + m * 16];
            }
#pragma unroll
            for (int bj = 0; bj < 2; ++bj) {
                const int np0 = (4 * u.pn + 2 * bj + (wc >> 1)) * 64;
                size_t off; int pitch, dcol, mode;
                if (np0 < 512) { off = WS_AQ; pitch = 512; dcol = np0; mode = 2; }
                else if (np0 < 576) { off = WS_AK; pitch = 64; dcol = 0; mode = 1; }
                else if (np0 < 640) { off = WS_AV; pitch = 64; dcol = 0; mode = 0; }
                else if (np0 < 896) { off = WS_IQ; pitch = 256; dcol = np0 - 640; mode = 1; }
                else if (np0 < 960) { off = WS_IK; pitch = 64; dcol = 0; mode = 1; }
                else if (np0 < 1472) { off = WS_BQ; pitch = 512; dcol = np0 - 960; mode = 2; }
                else if (np0 < 1600) { off = WS_BK; pitch = 128; dcol = np0 - 1472; mode = 1; }
                else if (np0 < 1728) { off = WS_BV; pitch = 128; dcol = np0 - 1600; mode = 0; }
                else if (np0 < 2240) { off = WS_CQ; pitch = 512; dcol = np0 - 1728; mode = 2; }
                else if (np0 < 2752) { off = WS_CK; pitch = 512; dcol = np0 - 2240; mode = 1; }
                else if (np0 < 3264) { off = WS_CV; pitch = 512; dcol = np0 - 2752; mode = 0; }
                else { off = WS_IW; pitch = 4; dcol = 0; mode = 3; }
                bf16_t* dst = (bf16_t*)(ws + off);
                const float sc = (mode == 2) ? C2 : 1.0f;
#pragma unroll
                for (int m = 0; m < 4; ++m) {
                    const int row = row0 + ai * 128 + m * 16;
                    const f32x4 v0 = acc[ai][bj][m][0] * rs[m], v1 = acc[ai][bj][m][1] * rs[m];
                    if (mode == 0) {
                        u32x4 w; w.x = pk2(v0[0], v0[1]); w.y = pk2(v0[2], v0[3]); w.z = pk2(v1[0], v1[1]); w.w = pk2(v1[2], v1[3]);
                        *(u32x4*)(dst + (size_t)row * pitch + dcol + 8 * j) = w;
                    } else if (mode == 3) {
                        if (j == 0) *(f32x4*)((float*)(ws + off) + (size_t)row * 4) = v0;
                    } else {
                        const f32x4 x1 = {v0[0], v0[2], v1[0], v1[2]}, x2 = {v0[1], v0[3], v1[1], v1[3]};
                        const f32x4 o1 = (x1 * c4[m] - x2 * s4[m]) * sc, o2 = (x1 * s4[m] + x2 * c4[m]) * sc;
                        u32x2 a, b; a.x = pk2(o1[0], o1[1]); a.y = pk2(o1[2], o1[3]); b.x = pk2(o2[0], o2[1]); b.y = pk2(o2[2], o2[3]);
                        bf16_t* p = dst + (size_t)row * pitch + dcol + 4 * j;
                        *(u32x2*)p = a; *(u32x2*)(p + 32) = b;
                    }
                }
            }
            asm volatile("" ::: "memory");
        }
    }
};
template <int ACT> struct EpiActMK {
    static constexpr bool PERM = true, AFTER_DRAIN = false;
    const LAS float* tab; bf16_t* O; int ldc;
    DEVI void operator()(const f32x4 (&acc)[2][2][4][2], const pg8::Unit& u, int wr, int wc, int fr, int fq) const {
        const int row0 = u.pm * 256 + wr * 64 + fr, col0 = u.pn * 256 + wc * 32 + 8 * fq;
#pragma unroll
        for (int ai = 0; ai < 2; ++ai)
#pragma unroll
            for (int m = 0; m < 4; ++m) {
                const int row = row0 + ai * 128 + m * 16; const float rs = tab[u.ord * 256 + wr * 64 + fr + ai * 128 + m * 16];
#pragma unroll
                for (int bj = 0; bj < 2; ++bj) {
                    float v[8];
#pragma unroll
                    for (int e = 0; e < 4; ++e) { v[e] = acc[ai][bj][m][0][e] * rs; v[4 + e] = acc[ai][bj][m][1][e] * rs; }
#pragma unroll
                    for (int e = 0; e < 8; ++e) {
                        if (ACT == 0) v[e] = __builtin_amdgcn_rcpf(1.0f + __expf(-v[e]));
                        else { const float t = fmaxf(v[e], 0.f); v[e] = t * t; }
                    }
                    u32x4 w; w.x = pk2(v[0], v[1]); w.y = pk2(v[2], v[3]); w.z = pk2(v[4], v[5]); w.w = pk2(v[6], v[7]);
                    *(u32x4*)(O + (size_t)row * ldc + col0 + bj * 128) = w;
                }
            }
    }
};
struct BranchOrder {
    pg8::StaticOrder S;
    __device__ bool next(int i, pg8::Unit& u) const { pg8::Unit t; const int ti = i / 3, br = i - 3 * ti; if (!S.next(ti, t)) return false; u.pm = 64 * br + t.pm; u.pn = 4 * br + t.pn; u.ord = br; return true; }
    DEVI void a_ready(const pg8::Unit&) const {}
    DEVI void done(const pg8::Unit&) const {}
};
struct EpiBranchMK {
    static constexpr bool PERM = true, AFTER_DRAIN = false;
    const bf16_t* GS; bf16_t* MG;
    DEVI void operator()(const f32x4 (&acc)[2][2][4][2], const pg8::Unit& u, int wr, int wc, int fr, int fq) const {
        const int br = u.ord;
        const int row0 = (u.pm - 64 * br) * 256 + wr * 64 + fr, col0 = (u.pn - 4 * br) * 256 + wc * 32 + 8 * fq;
#pragma unroll
        for (int ai = 0; ai < 2; ++ai) {
            u32x4 gg[4][2], oo[4][2];
#pragma unroll
            for (int m = 0; m < 4; ++m)
#pragma unroll
                for (int bj = 0; bj < 2; ++bj) {
                    const int row = row0 + ai * 128 + m * 16, col = col0 + bj * 128;
                    gg[m][bj] = *(const u32x4*)(GS + (size_t)row * 3072 + br * 1024 + col);
                    oo[m][bj] = (br > 0) ? *(const u32x4*)(MG + (size_t)row * 1024 + col) : (u32x4){0u, 0u, 0u, 0u};
                }
#pragma unroll
            for (int m = 0; m < 4; ++m)
#pragma unroll
                for (int bj = 0; bj < 2; ++bj) {
                    const int row = row0 + ai * 128 + m * 16, col = col0 + bj * 128;
                    const u32x4 g = gg[m][bj], o = oo[m][bj];
                    float v[8];
                    v[0] = bflo(g.x) * acc[ai][bj][m][0][0]; v[1] = bfhi(g.x) * acc[ai][bj][m][0][1]; v[2] = bflo(g.y) * acc[ai][bj][m][0][2]; v[3] = bfhi(g.y) * acc[ai][bj][m][0][3];
                    v[4] = bflo(g.z) * acc[ai][bj][m][1][0]; v[5] = bfhi(g.z) * acc[ai][bj][m][1][1]; v[6] = bflo(g.w) * acc[ai][bj][m][1][2]; v[7] = bfhi(g.w) * acc[ai][bj][m][1][3];
                    if (br > 0) { v[0] += bflo(o.x); v[1] += bfhi(o.x); v[2] += bflo(o.y); v[3] += bfhi(o.y); v[4] += bflo(o.z); v[5] += bfhi(o.z); v[6] += bflo(o.w); v[7] += bfhi(o.w); }
                    u32x4 w; w.x = pk2(v[0], v[1]); w.y = pk2(v[2], v[3]); w.z = pk2(v[4], v[5]); w.w = pk2(v[6], v[7]);
                    *(u32x4*)(MG + (size_t)row * 1024 + col) = w;
                }
            asm volatile("" ::: "memory");
        }
    }
};
struct EpiResMK {
    static constexpr bool PERM = true, AFTER_DRAIN = false;
    const float* xin; float* out; const float* g; bf16_t* XG; float* SSQ;
    DEVI void operator()(const f32x4 (&acc)[2][2][4][2], const pg8::Unit& u, int wr, int wc, int fr, int fq) const {
        const int row0 = u.pm * 256 + wr * 64 + fr, col0 = u.pn * 256 + wc * 32 + 8 * fq;
        f32x4 gv[2][2];
#pragma unroll
        for (int bj = 0; bj < 2; ++bj) { if (g) { gv[bj][0] = *(const f32x4*)(g + col0 + bj * 128); gv[bj][1] = *(const f32x4*)(g + col0 + bj * 128 + 4); } else { gv[bj][0] = (f32x4){1.f, 1.f, 1.f, 1.f}; gv[bj][1] = gv[bj][0]; } }
#pragma unroll
        for (int ai = 0; ai < 2; ++ai)
#pragma unroll
        for (int mh = 0; mh < 2; ++mh) {
            f32x4 xr[2][2][2];
#pragma unroll
            for (int mm = 0; mm < 2; ++mm)
#pragma unroll
                for (int bj = 0; bj < 2; ++bj) { const size_t o = (size_t)(row0 + ai * 128 + (2 * mh + mm) * 16) * 1024 + col0 + bj * 128; xr[mm][bj][0] = *(const f32x4*)(xin + o); xr[mm][bj][1] = *(const f32x4*)(xin + o + 4); }
#pragma unroll
            for (int mm = 0; mm < 2; ++mm) {
                const int m = 2 * mh + mm;
                const int row = row0 + ai * 128 + m * 16;
                float s = 0.f;
#pragma unroll
                for (int bj = 0; bj < 2; ++bj) {
                    const size_t o = (size_t)row * 1024 + col0 + bj * 128;
                    const f32x4 y0 = xr[mm][bj][0] + acc[ai][bj][m][0], y1 = xr[mm][bj][1] + acc[ai][bj][m][1];
                    *(f32x4*)(out + o) = y0; *(f32x4*)(out + o + 4) = y1;
                    s += (y0[0] * y0[0] + y0[1] * y0[1]) + (y0[2] * y0[2] + y0[3] * y0[3]) + (y1[0] * y1[0] + y1[1] * y1[1]) + (y1[2] * y1[2] + y1[3] * y1[3]);
                    if (g) {
                        const f32x4 z0 = y0 * gv[bj][0], z1 = y1 * gv[bj][1];
                        u32x4 w; w.x = pk2(z0[0], z0[1]); w.y = pk2(z0[2], z0[3]); w.z = pk2(z1[0], z1[1]); w.w = pk2(z1[2], z1[3]);
                        *(u32x4*)(XG + o) = w;
                    }
                }
                { const int ln = fq * 16 + fr; s += bperm_xor(s, ln, 16); s += bperm_xor(s, ln, 32); }
                if (fq == 0) SSQ[(size_t)row * 16 + u.pn * 4 + wc] = s;
            }
            asm volatile("" ::: "memory");
        }
    }
};


#define XB_TMO      128
#define XB_XCNT(j)  (256  + 64 * (j))
#define XB_XSUB(j)  (1280 + 64 * (j))
#define XB_XGEN(j)  (2304 + 64 * (j))
#define XB_TOP      3328
#define XB_TOPGEN   3392
#define XB_SLOT(b)  (4096 + 2 * (b))
#define XB_SPIN_CAP (1u << 20)
constexpr size_t CTL_ZERO_BYTES = 32768;
DEVI unsigned xb_ld(unsigned* p)              { return __hip_atomic_load(p, __ATOMIC_RELAXED, __HIP_MEMORY_SCOPE_AGENT); }
DEVI unsigned xb_add(unsigned* p, unsigned v) { return __hip_atomic_fetch_add(p, v, __ATOMIC_RELAXED, __HIP_MEMORY_SCOPE_AGENT); }
DEVI unsigned xb_xcc_id() { return (unsigned)__builtin_amdgcn_s_getreg((3 << 11) | 20) & 0xFu; }
#define XB_SPIN(cond, bar) do { unsigned _sp = 0; while (cond) { __builtin_amdgcn_s_sleep(1); \
    if ((++_sp & 255u) == 0u) { if (xb_ld(&(bar)[XB_TMO])) break; if (_sp > XB_SPIN_CAP) { atomicAdd(&(bar)[XB_TMO], 1u); break; } } } } while (0)
DEVI void xcd_barrier_complete(unsigned* bar, unsigned x, unsigned& nloc, unsigned& nx) {
    const unsigned G = gridDim.x * gridDim.y * gridDim.z;
    unsigned sum, cnt, mine, sp = 0u;
    for (;;) {
        sum = 0u; cnt = 0u; mine = 0u;
#pragma unroll
        for (unsigned j = 0; j < 16; ++j) { const unsigned c = xb_ld(&bar[XB_XCNT(j)]); sum += c; cnt += (c > 0u) ? 1u : 0u; mine = (j == x) ? c : mine; }
        if (sum == G) break;
        __builtin_amdgcn_s_sleep(1);
        if ((++sp & 255u) == 0u) { if (xb_ld(&bar[XB_TMO])) break; if (sp > XB_SPIN_CAP) { atomicAdd(&bar[XB_TMO], 1u); break; } }
    }
    nloc = mine > 0u ? mine : 1u; nx = cnt > 0u ? cnt : 1u;
}
DEVI void xcd_barrier(unsigned* bar, bool tid0) {
    asm volatile("s_waitcnt vmcnt(0)" ::: "memory");
    __syncthreads();
    if (tid0) {
        __builtin_amdgcn_s_waitcnt(0);
        const unsigned x = xb_xcc_id();
        volatile unsigned* st = bar + XB_SLOT(blockIdx.x);
        unsigned nloc = st[0], nx = st[1];
        if (nloc == 0u) { xcd_barrier_complete(bar, x, nloc, nx); st[0] = nloc; st[1] = nx; }
        const unsigned old = xb_add(&bar[XB_XSUB(x)], 1u);
        const unsigned gen = old / nloc;
        if (old + 1u == (gen + 1u) * nloc) {
            __builtin_amdgcn_fence(__ATOMIC_RELEASE, "agent");
            asm volatile("s_waitcnt vmcnt(0)" ::: "memory");
            const unsigned og = xb_add(&bar[XB_TOP], 1u);
            const unsigned tg = og / nx;
            if (og + 1u == (tg + 1u) * nx) xb_add(&bar[XB_TOPGEN], 1u);
            else XB_SPIN(xb_ld(&bar[XB_TOPGEN]) == tg, bar);
            __builtin_amdgcn_fence(__ATOMIC_ACQUIRE, "agent");
            xb_add(&bar[XB_XGEN(x)], 1u);
            asm volatile("s_waitcnt vmcnt(0)" ::: "memory");
        } else {
            XB_SPIN(xb_ld(&bar[XB_XGEN(x)]) == gen, bar);
            __builtin_amdgcn_fence(__ATOMIC_ACQUIRE, "agent");
            asm volatile("s_waitcnt vmcnt(0)" ::: "memory");
        }
    }
    __syncthreads();
}

namespace dsa {
typedef short bf16x8 __attribute__((ext_vector_type(8)));
typedef short s16x4 __attribute__((ext_vector_type(4)));
typedef float f32x4 __attribute__((ext_vector_type(4)));
typedef unsigned u32x4 __attribute__((ext_vector_type(4)));
typedef __attribute__((address_space(3))) unsigned lds_u32;
typedef __attribute__((address_space(3))) unsigned short lds_u16;
typedef __attribute__((address_space(3))) unsigned char lds_u8;
constexpr int WAVE_LDS = 16384;
constexpr int OFF_SEL = 14336;
constexpr int OFF_STG = 8 * WAVE_LDS;
constexpr int STG_BYTES = 16384;
constexpr int DSA_LDS = OFF_STG + 2 * STG_BYTES;
constexpr int VROW = 144;

DEVI int bperm_i(int v, int srclane) { return __builtin_amdgcn_ds_bpermute(srclane << 2, v); }

DEVI void chunk_scores(unsigned (&u)[4], const bf16x8 (&bfr)[4][2], const bf16x8& a0, const bf16x8& a1, const f32x4& w) {
    f32x4 cc[4];
#pragma unroll
    for (int t = 0; t < 4; ++t) cc[t] = __builtin_amdgcn_mfma_f32_16x16x32_bf16(a0, bfr[t][0], (f32x4){0.f, 0.f, 0.f, 0.f}, 0, 0, 0);
#pragma unroll
    for (int t = 0; t < 4; ++t) cc[t] = __builtin_amdgcn_mfma_f32_16x16x32_bf16(a1, bfr[t][1], cc[t], 0, 0, 0);
#pragma unroll
    for (int t = 0; t < 4; ++t) {
        const f32x4 c = cc[t];
        float r0, r1, r2, r3;
        { int i0_ = __float_as_int(c[0]), i1_ = __float_as_int(c[1]), i2_ = __float_as_int(c[2]), i3_ = __float_as_int(c[3]);
          r0 = __int_as_float(i0_ > 0 ? i0_ : 0); r1 = __int_as_float(i1_ > 0 ? i1_ : 0); r2 = __int_as_float(i2_ > 0 ? i2_ : 0); r3 = __int_as_float(i3_ > 0 ? i3_ : 0); }
        float s = w[0] * r0; s = fmaf(w[1], r1, s); s = fmaf(w[2], r2, s); s = fmaf(w[3], r3, s);
        s = s + 0.0f;
        const int b = __float_as_int(s);
        u[t] = (unsigned)(b ^ ((b >> 31) | (int)0x80000000));
    }
}
constexpr unsigned CAND_CAP = 597u;
DEVI unsigned kbin(unsigned u) {
    const bool pos = (int)u < 0;
    const unsigned x = pos ? u : ~u;
    int m = (int)(x >> 19) - 5632; m = m < 0 ? 0 : m;
    const int mp = m > 1022 ? 1022 : m, mn = m > 1023 ? 1023 : m;
    return (u == 0x80000000u) ? 1024u : (pos ? (unsigned)(1025 + mp) : (unsigned)(1023 - mn));
}
struct PassState { unsigned prefix, T, need, cnt, eqc; unsigned mode; lds_u16* aux; };
template <int PASS>
DEVI void chunk_work(const unsigned (&u)[4], int kc, int qpos, int g, int n16, lds_u32* hist, lds_u16* sel, PassState& st) {
    const unsigned below = (1u << n16) - 1u;
#pragma unroll
    for (int t = 0; t < 4; ++t) {
        const int key = kc + t * 16 + n16; const bool valid = key <= qpos;
        if (PASS == 7) { const unsigned bn = kbin(u[t]); __hip_atomic_fetch_add(hist + (bn >> 1), valid ? (1u << (16 * (bn & 1u))) : 0u, __ATOMIC_RELAXED, __HIP_MEMORY_SCOPE_WORKGROUP); }
        else if (PASS == 8) {
            const bool cand = valid && u[t] >= st.T;
            const unsigned mc = (unsigned)((__builtin_amdgcn_ballot_w64(u[t] >= st.T) & __builtin_amdgcn_ballot_w64(valid)) >> (16 * g)) & 0xffffu;
            const unsigned pc = st.cnt + (unsigned)__popc(mc & below);
            if (cand && pc < CAND_CAP) { hist[pc] = u[t]; st.aux[pc] = (unsigned short)key; }
            st.cnt += (unsigned)__popc(mc);
            if (st.need) {
                const bool zdir = valid && st.mode && (u[t] == 0x80000000u);
                const unsigned mz = (unsigned)(__builtin_amdgcn_ballot_w64(zdir) >> (16 * g)) & 0xffffu;
                const unsigned pz = st.eqc + (unsigned)__popc(mz & below);
                if (zdir && pz < 256u) sel[pz] = (unsigned short)key;
                st.eqc += (unsigned)__popc(mz);
            }
        }
        else if (PASS == 1) { const unsigned bn = u[t] >> 21; __hip_atomic_fetch_add(hist + (bn >> 1), valid ? (1u << (16 * (bn & 1u))) : 0u, __ATOMIC_RELAXED, __HIP_MEMORY_SCOPE_WORKGROUP); }
        else if (PASS == 2) { if (valid && (u[t] >> 21) == st.prefix) { const unsigned bn = (u[t] >> 10) & 0x7ffu; __hip_atomic_fetch_add(hist + (bn >> 1), 1u << (16 * (bn & 1u)), __ATOMIC_RELAXED, __HIP_MEMORY_SCOPE_WORKGROUP); } }
        else if (PASS == 3) { if (valid && (u[t] >> 10) == st.prefix) { const unsigned bn = u[t] & 0x3ffu; __hip_atomic_fetch_add(hist + (bn >> 1), 1u << (16 * (bn & 1u)), __ATOMIC_RELAXED, __HIP_MEMORY_SCOPE_WORKGROUP); } }
        else if (PASS == 4) {
            const bool take = valid && u[t] > st.T;
            const unsigned msel = (unsigned)((__builtin_amdgcn_ballot_w64(u[t] > st.T) & __builtin_amdgcn_ballot_w64(valid)) >> (16 * g)) & 0xffffu;
            const unsigned pos = st.cnt + (unsigned)__popc(msel & below);
            if (take && pos < 256u) sel[pos] = (unsigned short)key;
            st.cnt += (unsigned)__popc(msel);
        } else {
            const bool gt = valid && u[t] > st.T, eq = valid && u[t] == st.T;
            const unsigned meq = (unsigned)(__builtin_amdgcn_ballot_w64(eq) >> (16 * g)) & 0xffffu;
            const bool take = gt || (eq && (st.eqc + (unsigned)__popc(meq & below)) < st.need);
            const unsigned msel = (unsigned)(__builtin_amdgcn_ballot_w64(take) >> (16 * g)) & 0xffffu;
            const unsigned pos = st.cnt + (unsigned)__popc(msel & below);
            if (take && pos < 256u) sel[pos] = (unsigned short)key;
            st.cnt += (unsigned)__popc(msel); st.eqc += (unsigned)__popc(meq);
        }
    }
}
template <int PASS, int STRIDE>
DEVI void run_pass_blk(const bf16_t* IKb, int nst, int tid, int lane, const bf16x8& a0, const bf16x8& a1, const f32x4& w, int qpos, int qmaxw, lds_u32* hist, lds_u16* sel, PassState& st, lds_u8* stg) {
    const int g = lane >> 4, n16 = lane & 15;
    const int srow = tid >> 3, sch = tid & 7;
    const bf16_t* gp = IKb + (size_t)srow * 64 + sch * 8;
    const int woff = srow * 128 + ((sch ^ ((srow >> 1) & 7)) << 4);
    const int sw = (n16 >> 1) & 7;
    const int roff0 = n16 * 128 + ((g ^ sw) << 4), roff1 = n16 * 128 + (((g + 4) ^ sw) << 4);
#define DSA_LOAD(RA, RB, st_) do { const int s_ = ((st_) < nst) ? (st_) : nst - 1; const bf16_t* gn = gp + (size_t)s_ * (STRIDE * 128 * 64); RA = *(const u32x4*)gn; RB = *(const u32x4*)(gn + 64 * 64); } while (0)
#define DSA_WRITE(RA, RB, bufoff) do { *(__attribute__((address_space(3))) u32x4*)(stg + (bufoff) + woff) = RA; *(__attribute__((address_space(3))) u32x4*)(stg + (bufoff) + 8192 + woff) = RB; } while (0)
#define DSA_COMPUTE(st_, bufoff) do { bf16x8 bfr[2][4][2];                   \
        _Pragma("unroll") for (int h = 0; h < 2; ++h) _Pragma("unroll") for (int t = 0; t < 4; ++t) { \
            bfr[h][t][0] = *(const __attribute__((address_space(3))) bf16x8*)(stg + (bufoff) + h * 8192 + t * 2048 + roff0); \
            bfr[h][t][1] = *(const __attribute__((address_space(3))) bf16x8*)(stg + (bufoff) + h * 8192 + t * 2048 + roff1); } \
        __builtin_amdgcn_sched_barrier(0); \
        _Pragma("unroll") for (int h = 0; h < 2; ++h) { const int kc = (st_) * (STRIDE * 128) + h * 64; if (kc <= qmaxw) { \
            unsigned u[4]; chunk_scores(u, bfr[h], a0, a1, w); chunk_work<PASS>(u, kc, qpos, g, n16, hist, sel, st); } } } while (0)
#define DSA_BAR() do { asm volatile("s_waitcnt lgkmcnt(0)" ::: "memory"); __builtin_amdgcn_s_barrier(); } while (0)
    u32x4 p0, p1, q0r, q1r;
    DSA_LOAD(p0, p1, 0); DSA_WRITE(p0, p1, 0); DSA_LOAD(q0r, q1r, 1);
    DSA_BAR();
    for (int s = 0; s < nst; s += 2) {
        DSA_LOAD(p0, p1, s + 2);
        DSA_COMPUTE(s, 0);
        DSA_WRITE(q0r, q1r, STG_BYTES);
        DSA_BAR();
        if (s + 1 < nst) {
            DSA_LOAD(q0r, q1r, s + 3);
            DSA_COMPUTE(s + 1, STG_BYTES);
            DSA_WRITE(p0, p1, 0);
            DSA_BAR();
        }
    }
#undef DSA_LOAD
#undef DSA_WRITE
#undef DSA_COMPUTE
#undef DSA_BAR
}
DEVI void scan_level(lds_u32* hist, int wpl, unsigned K, int lane, unsigned& bin, unsigned& Knew, unsigned& cbin, unsigned fracn = 0u) {
    const int i = lane & 15, g = lane >> 4;
    const lds_u32* hw = hist + i * wpl;
    const int spb = wpl >> 3;
    unsigned sb[8]; unsigned sum = 0u;
#pragma unroll
    for (int q = 0; q < 8; ++q) {
        unsigned s = 0u;
        for (int x = 0; x < spb; x += 4) { const u32x4 v = *(const __attribute__((address_space(3))) u32x4*)(hw + q * spb + x); s += (v.x & 0xffffu) + (v.x >> 16) + (v.y & 0xffffu) + (v.y >> 16) + (v.z & 0xffffu) + (v.z >> 16) + (v.w & 0xffffu) + (v.w >> 16); }
        sb[q] = s; sum += s;
    }
    unsigned suf = sum;
#pragma unroll
    for (int off = 1; off < 16; off <<= 1) { const unsigned t = (unsigned)bperm_i((int)suf, lane + off); if (i + off < 16) suf += t; }
    if (fracn) { const unsigned tot = (unsigned)bperm_i((int)suf, 16 * g); K = (tot * 380u + fracn - 1u) / fracn; K = K ? K : 1u; }
    const unsigned above = suf - sum;
    const bool found = (above < K && K <= suf);
    unsigned b = 0u, kn = 0u, cb = 0u;
    if (found) {
        unsigned cum = above; int qs = 0;
#pragma unroll
        for (int q = 7; q >= 0; --q) { if (qs == 0 && cum + sb[q] >= K) qs = q + 1; if (qs == 0) cum += sb[q]; }
        const int w0 = (qs - 1) * spb;
        for (int wi = w0 + spb - 1; wi >= w0; --wi) {
            const unsigned v = hw[wi]; const unsigned hi = v >> 16, lo = v & 0xffffu;
            if (cum + hi >= K) { b = (unsigned)(2 * (i * wpl + wi) + 1); kn = K - cum; cb = hi; break; }
            cum += hi;
            if (cum + lo >= K) { b = (unsigned)(2 * (i * wpl + wi)); kn = K - cum; cb = lo; break; }
            cum += lo;
        }
    }
    const unsigned gm = (unsigned)(__builtin_amdgcn_ballot_w64(found) >> (16 * g)) & 0xffffu;
    const int src = 16 * g + (gm ? __ffs((int)gm) - 1 : 0);
    bin = (unsigned)bperm_i((int)b, src); Knew = (unsigned)bperm_i((int)kn, src); cbin = (unsigned)bperm_i((int)cb, src);
}
DEVI void zero_hist(lds_u8* wl, int lane) {
    const u32x4 z = {0u, 0u, 0u, 0u};
#pragma unroll
    for (int x = 0; x < 16; ++x) *(__attribute__((address_space(3))) u32x4*)(wl + (x * 64 + lane) * 16) = z;
    asm volatile("s_waitcnt lgkmcnt(0)" ::: "memory");
}
DEVI bool block_any(bool flag, lds_u8* stg, int tid) {
    lds_u32* vw = (lds_u32*)stg;
    if (tid == 0) vw[0] = 0u;
    asm volatile("s_waitcnt lgkmcnt(0)" ::: "memory"); __builtin_amdgcn_s_barrier();
    if (flag && (tid & 63) == 0) vw[0] = 1u;
    asm volatile("s_waitcnt lgkmcnt(0)" ::: "memory"); __builtin_amdgcn_s_barrier();
    const bool r = vw[0] != 0u;
    asm volatile("s_waitcnt lgkmcnt(0)" ::: "memory"); __builtin_amdgcn_s_barrier();
    return r;
}

DEVI unsigned gsum16(unsigned v, int lane) { v += (unsigned)bperm_i((int)v, lane ^ 1); v += (unsigned)bperm_i((int)v, lane ^ 2); v += (unsigned)bperm_i((int)v, lane ^ 4); v += (unsigned)bperm_i((int)v, lane ^ 8); return v; }
DEVI unsigned xpre16(unsigned v, int lane) {
    const int i = lane & 15; unsigned s = v;
#pragma unroll
    for (int off = 1; off < 16; off <<= 1) { const unsigned t = (unsigned)bperm_i((int)s, lane - off); if (i >= off) s += t; }
    return s - v;
}
DEVI void resolve_cands(const lds_u32* cu, const lds_u16* ck, unsigned c, lds_u16* sel, int lane) {
    const int i = lane & 15;
    const unsigned per = (c + 15u) >> 4;
    const unsigned j0 = (i * per < c) ? i * per : c, j1 = (j0 + per < c) ? j0 + per : c;
    unsigned cr[38];
#pragma unroll
    for (int x = 0; x < 38; ++x) cr[x] = (j0 + x < j1) ? cu[j0 + x] : 0u;
    unsigned prefix = 0u;
#pragma unroll 1
    for (int bit = 31; bit >= 0; --bit) {
        const unsigned trial = prefix | (1u << bit); unsigned cnt = 0u;
#pragma unroll
        for (int x = 0; x < 38; ++x) cnt += (cr[x] >= trial) ? 1u : 0u;
        if (gsum16(cnt, lane) >= 256u) prefix = trial;
    }
    const unsigned T = prefix;
    unsigned gtl = 0u, eql = 0u;
#pragma unroll
    for (int x = 0; x < 38; ++x) { gtl += (cr[x] > T) ? 1u : 0u; eql += (cr[x] == T && j0 + x < j1) ? 1u : 0u; }
    const unsigned need = 256u - gsum16(gtl, lane);
    const unsigned eqb = xpre16(eql, lane);
    const unsigned teq = (eqb >= need) ? 0u : ((need - eqb < eql) ? need - eqb : eql);
    unsigned pos = xpre16(gtl + teq, lane), eqs = 0u;
#pragma unroll
    for (int x = 0; x < 38; ++x) {
        const bool in = j0 + x < j1;
        const bool tk = in && (cr[x] > T || (cr[x] == T && eqs < teq));
        if (in && cr[x] == T) ++eqs;
        if (tk) { if (pos < 256u) sel[pos] = ck[j0 + x]; ++pos; }
    }
}
DEVI void group(int b, int q0, const bf16_t* IQ, const bf16_t* IK, const float* IW, const bf16_t* AQ_O, bf16_t* OUT_O, const bf16_t* AK, const bf16_t* AV, lds_u8* wl, lds_u8* stg, int Q0, int tid, int lane) {
    const int g = lane >> 4, n16 = lane & 15;
    const size_t m0 = (size_t)b * SEQ + q0;
    lds_u32* hist = (lds_u32*)wl + g * 1024;
    lds_u16* sel = (lds_u16*)(wl + OFF_SEL) + g * 256;
    const int qpos = q0 + g;
    if (Q0 + 31 < 256) {
        for (int k = n16; k < 256; k += 16) sel[k] = (unsigned short)k;
    } else {
        const bf16_t* IKb = IK + (size_t)b * SEQ * 64;
        bf16x8 a0, a1; f32x4 w;
        { const bf16_t* pq = IQ + (m0 + (n16 >> 2)) * 256 + (n16 & 3) * 64 + 8 * g; a0 = *(const bf16x8*)pq; a1 = *(const bf16x8*)(pq + 32); w = *(const f32x4*)(IW + (m0 + g) * 4); }
        const int nst = (Q0 + 32 + 127) >> 7;
        unsigned K = 256u, bin = 0u, cb = 0u;
        PassState st; st.prefix = 0u; st.T = 0u; st.need = 0u; st.cnt = 0u; st.eqc = 0u; st.mode = 0u; st.aux = nullptr;
        bool need_exact = true;
        if (nst >= 8) {
            lds_u32* cu = (lds_u32*)(wl + g * 3584); lds_u16* ck = (lds_u16*)(wl + g * 3584 + 2388);
            zero_hist(wl, lane);
            run_pass_blk<7, 2>(IKb, (nst + 1) >> 1, tid, lane, a0, a1, w, qpos, q0 + 3, hist, sel, st, stg);
            unsigned kd = 0u, cbd = 0u;
            scan_level(hist, 64, 96u, lane, bin, kd, cbd, (unsigned)(qpos + 1));
            PassState ss; ss.prefix = bin; ss.cnt = 0u; ss.eqc = 0u; ss.mode = (bin == 1024u) ? 1u : 0u; ss.aux = ck;
            ss.T = (bin >= 1026u) ? ((4607u + bin) << 19) : (bin >= 1024u) ? 0x80000001u : (bin == 0u) ? 0u : ~(((6656u - bin) << 19) - 1u);
            ss.need = __any(ss.mode != 0u) ? 1u : 0u;
#if defined(DSA_DBL_P8)
            run_pass_blk<8, 1>(IKb, nst, tid, lane, a0, a1, w, qpos, q0 + 3, cu, sel, ss, stg); ss.cnt = 0u; ss.eqc = 0u;
#endif
            run_pass_blk<8, 1>(IKb, nst, tid, lane, a0, a1, w, qpos, q0 + 3, cu, sel, ss, stg);
            const unsigned c = ss.cnt, z = ss.eqc;
            const bool zfill = ss.mode && c < 256u;
            const bool bad = (c > CAND_CAP) || (zfill ? (c + z < 256u) : (c < 256u));
            need_exact = block_any(__any(bad), stg, tid);
#if defined(DSA_NOFALLBACK)
            need_exact = false;
#endif
            if (!need_exact) {
                if (zfill) { for (unsigned x = (unsigned)n16; x < c; x += 16u) sel[256u - c + x] = ck[x]; }
                else {
#if defined(DSA_DBL_RES)
                    resolve_cands(cu, ck, c, sel, lane);
#endif
                    resolve_cands(cu, ck, c, sel, lane); }
            }
        }
        if (need_exact) {
#if defined(DSA_DBL_P1)
        zero_hist(wl, lane);
        run_pass_blk<1, 1>(IKb, nst, tid, lane, a0, a1, w, qpos, q0 + 3, hist, sel, st, stg);
#endif
        zero_hist(wl, lane);
        run_pass_blk<1, 1>(IKb, nst, tid, lane, a0, a1, w, qpos, q0 + 3, hist, sel, st, stg);
        scan_level(hist, 64, K, lane, bin, K, cb); st.prefix = bin;
#if defined(DSA_DBL_P2)
        zero_hist(wl, lane);
        run_pass_blk<2, 1>(IKb, nst, tid, lane, a0, a1, w, qpos, q0 + 3, hist, sel, st, stg);
#endif
        zero_hist(wl, lane);
        run_pass_blk<2, 1>(IKb, nst, tid, lane, a0, a1, w, qpos, q0 + 3, hist, sel, st, stg);
        scan_level(hist, 64, K, lane, bin, K, cb);
        const unsigned p22 = (st.prefix << 11) | bin;
        const bool done2 = (cb == K) && (p22 != 0u);
        if (done2) { st.T = (p22 << 10) - 1u; st.need = 0u; st.prefix = 0xffffffffu; } else { st.prefix = p22; }
        if (block_any(__any(!done2), stg, tid)) {
            zero_hist(wl, lane);
            run_pass_blk<3, 1>(IKb, nst, tid, lane, a0, a1, w, qpos, q0 + 3, hist, sel, st, stg);
            if (!done2) {
                scan_level(hist, 32, K, lane, bin, K, cb);
                st.T = (p22 << 10) | bin; st.need = K;
                if (cb == K && st.T != 0u) { st.T -= 1u; st.need = 0u; }
            }
        }
        if (block_any(__any(st.need != 0u), stg, tid)) run_pass_blk<5, 1>(IKb, nst, tid, lane, a0, a1, w, qpos, q0 + 3, hist, sel, st, stg);
        else run_pass_blk<4, 1>(IKb, nst, tid, lane, a0, a1, w, qpos, q0 + 3, hist, sel, st, stg);
        }
    }
    asm volatile("s_waitcnt lgkmcnt(0)" ::: "memory");
    const bf16_t* AKb = AK + (size_t)b * SEQ * 64; const bf16_t* AVb = AV + (size_t)b * SEQ * 64;
    const lds_u16* selw = (const lds_u16*)(wl + OFF_SEL);
#if defined(DSA_DBL_ATT)
#define DSA_NJ 8
#else
#define DSA_NJ 4
#endif
#pragma unroll 1
    for (int jl = 0; jl < DSA_NJ; ++jl) {
        int j = jl & 3; asm volatile("" : "+s"(j));
        const int qp = q0 + j; const int cntj = (qp + 1 < 256) ? qp + 1 : 256;
        const lds_u16* sj = selw + j * 256;
        bf16x8 qf0 = {0, 0, 0, 0, 0, 0, 0, 0}, qf1 = qf0;
        if (n16 < 8) { const bf16_t* pq = AQ_O + (m0 + j) * 512 + n16 * 64 + 8 * g; qf0 = *(const bf16x8*)pq; qf1 = *(const bf16x8*)(pq + 32); }
        u32x4 vr[2][8];
#define DSA_VLOAD(c_, buf_) do { _Pragma("unroll") for (int e = 0; e < 8; ++e) { const int pos_ = 64 * (c_) + e * 8 + (lane >> 3); const int key_ = (pos_ < cntj) ? (int)sj[pos_] : 0; \
            vr[buf_][e] = *(const u32x4*)(AVb + (size_t)key_ * 64 + (lane & 7) * 8); } } while (0)
        DSA_VLOAD(0, 0);
        f32x4 sc[16];
#pragma unroll
        for (int hf = 0; hf < 2; ++hf) {
            bf16x8 kf[8][2];
#pragma unroll
            for (int t = 0; t < 8; ++t) {
                const int pos = 16 * (8 * hf + t) + n16; const int key = (pos < cntj) ? (int)sj[pos] : 0;
                const bf16_t* pk = AKb + (size_t)key * 64 + 8 * g;
                kf[t][0] = *(const bf16x8*)pk; kf[t][1] = *(const bf16x8*)(pk + 32);
            }
#pragma unroll
            for (int t = 0; t < 8; ++t) {
                f32x4 c = {0.f, 0.f, 0.f, 0.f};
                c = __builtin_amdgcn_mfma_f32_16x16x32_bf16(kf[t][0], qf0, c, 0, 0, 0);
                c = __builtin_amdgcn_mfma_f32_16x16x32_bf16(kf[t][1], qf1, c, 0, 0, 0);
                sc[8 * hf + t] = c;
            }
        }
        float mx = -INFINITY;
#pragma unroll
        for (int t = 0; t < 16; ++t)
#pragma unroll
            for (int r = 0; r < 4; ++r) { if (16 * t + 4 * g + r >= cntj) sc[t][r] = -INFINITY; mx = fmaxf(mx, sc[t][r]); }
        mx = fmaxf(mx, bperm_xor(mx, lane, 16)); mx = fmaxf(mx, bperm_xor(mx, lane, 32));
        float sum = 0.f;
#pragma unroll
        for (int t = 0; t < 16; ++t)
#pragma unroll
            for (int r = 0; r < 4; ++r) { sc[t][r] = __builtin_amdgcn_exp2f(sc[t][r] - mx); sum += sc[t][r]; }
        sum += bperm_xor(sum, lane, 16); sum += bperm_xor(sum, lane, 32);
        const float inv = 1.0f / sum;
        unsigned pkp[16][2];
#pragma unroll
        for (int t = 0; t < 16; ++t) { pkp[t][0] = pk2(sc[t][0] * inv, sc[t][1] * inv); pkp[t][1] = pk2(sc[t][2] * inv, sc[t][3] * inv); }
        f32x4 o[4];
#pragma unroll
        for (int d = 0; d < 4; ++d) o[d] = (f32x4){0.f, 0.f, 0.f, 0.f};
#pragma unroll
        for (int c = 0; c < 4; ++c) {
            asm volatile("s_waitcnt lgkmcnt(0)" ::: "memory");
#pragma unroll
            for (int e = 0; e < 8; ++e) *(__attribute__((address_space(3))) u32x4*)(wl + (e * 8 + (lane >> 3)) * VROW + (lane & 7) * 16) = vr[c & 1][e];
            if (c < 3) DSA_VLOAD(c + 1, (c + 1) & 1);
            asm volatile("s_waitcnt lgkmcnt(0)" ::: "memory");
#pragma unroll
            for (int ks = 0; ks < 2; ++ks) {
                const int t0 = 4 * c + 2 * ks;
                bf16x8 pa; { u32x4 t4 = {pkp[t0][0], pkp[t0][1], pkp[t0 + 1][0], pkp[t0 + 1][1]}; pa = __builtin_bit_cast(bf16x8, t4); }
                const lds_u8* vb = wl + (32 * ks + 4 * g + (n16 >> 2)) * VROW + (n16 & 3) * 8;
#pragma unroll
                for (int d = 0; d < 4; ++d) {
                    const s16x4 lo = __builtin_bit_cast(s16x4, __builtin_amdgcn_ds_read_tr16_b64_v4i16((__attribute__((address_space(3))) s16x4*)(vb + d * 32)));
                    const s16x4 hi = __builtin_bit_cast(s16x4, __builtin_amdgcn_ds_read_tr16_b64_v4i16((__attribute__((address_space(3))) s16x4*)(vb + 16 * VROW + d * 32)));
                    const bf16x8 vf = {lo[0], lo[1], lo[2], lo[3], hi[0], hi[1], hi[2], hi[3]};
                    o[d] = __builtin_amdgcn_mfma_f32_16x16x32_bf16(pa, vf, o[d], 0, 0, 0);
                }
            }
        }
#undef DSA_VLOAD
        if (g < 2) {
            bf16_t* po = ((DSA_NJ == 8 && jl < 4) ? OUT_O + ((size_t)104 << 19) : OUT_O) + (m0 + j) * 512;
#pragma unroll
            for (int d = 0; d < 4; ++d)
#pragma unroll
                for (int r = 0; r < 4; ++r) po[(4 * g + r) * 64 + 16 * d + n16] = (bf16_t)(pk2(o[d][r], 0.f) & 0xffffu);
        }
    }
    asm volatile("s_waitcnt lgkmcnt(0)" ::: "memory");
}
}

#ifndef MK_DSA
#define MK_DSA 1
#endif
#ifndef MK_DBL
#define MK_DBL 0
#endif
enum { DBL_DSA = 0x200, DBL_SWA = 0x400 };
constexpr size_t WS_DUMMY = 176 * MiB;
struct MKArgs { const float* in[10]; float* out; unsigned char* ws; int l_lo, l_hi, pmask, fin; };
constexpr int MK_LDS = dsa::DSA_LDS;
#ifndef MK_EN
#define MK_EN 0x1ff
#endif
enum { PH_PREP = 1, PH_P1 = 2, PH_ATT1 = 4, PH_ATT2 = 8, PH_GATE = 16, PH_BRANCH = 32, PH_OUT = 64, PH_FF1 = 128, PH_FF2 = 256 };

constexpr int TR_I_IN = 16 * (NPERM / 32), TR_I_GATE = 16 * (3072 / 32), TR_I_BR = 8 * 32, TR_I_OUT = 16 * 32, TR_I_FF1 = 16 * 128, TR_I_FF2 = 64 * 32;
DEVI TrItem tr_decode(int it, int lane, const float* w_in, const float* w_br, const float* w_out, const float* w_ff1, const float* w_ff2, unsigned char* ws) {
    TrItem t; int r = it, kb, nb;
    if (r < TR_I_IN) { kb = r / (NPERM / 32); nb = r % (NPERM / 32); t.W = w_in; t.ldw = NIN; t.K = 1024; t.WT = (bf16_t*)(ws + WS_W + WO_IN); t.sc = win_src_col(32 * nb + (lane & 31)); }
    else if ((r -= TR_I_IN) < TR_I_GATE) { kb = r / 96; nb = r % 96; t.W = w_in; t.ldw = NIN; t.K = 1024; t.WT = (bf16_t*)(ws + WS_W + WO_GATE); t.sc = NPROJ + 32 * nb + (lane & 31); }
    else if ((r -= TR_I_GATE) < 3 * TR_I_BR) { const int br = r / TR_I_BR, q = r % TR_I_BR; kb = q / 32; nb = q % 32; t.W = w_br + (size_t)br * 512 * 1024; t.ldw = 1024; t.K = 512; t.WT = (bf16_t*)(ws + WS_W + WO_BR) + (size_t)br * 1024 * 512; t.sc = 32 * nb + (lane & 31); }
    else if ((r -= 3 * TR_I_BR) < TR_I_OUT) { kb = r / 32; nb = r % 32; t.W = w_out; t.ldw = 1024; t.K = 1024; t.WT = (bf16_t*)(ws + WS_W + WO_OUT); t.sc = 32 * nb + (lane & 31); }
    else if ((r -= TR_I_OUT) < TR_I_FF1) { kb = r / 128; nb = r % 128; t.W = w_ff1; t.ldw = DFF; t.K = 1024; t.WT = (bf16_t*)(ws + WS_W + WO_FF1); t.sc = 32 * nb + (lane & 31); }
    else { r -= TR_I_FF1; kb = r / 32; nb = r % 32; t.W = w_ff2; t.ldw = 1024; t.K = DFF; t.WT = (bf16_t*)(ws + WS_W + WO_FF2); t.sc = 32 * nb + (lane & 31); }
    t.k0 = 64 * kb; t.n0 = 32 * nb; return t;
}
typedef const __attribute__((address_space(4))) MKArgs* kargs_t;
#define KARGS(ka) kargs_t ka = (kargs_t)__builtin_amdgcn_kernarg_segment_ptr(); asm volatile("" : "+s"(ka))

__global__ void __launch_bounds__(512, 2) mk_fwd(MKArgs a_unused) {
    extern __shared__ __attribute__((aligned(16))) unsigned char lds_raw[];
    const int wave_s = __builtin_amdgcn_readfirstlane((int)threadIdx.x >> 6);
#define MK_TID() (wave_s * 64 + mk_lane_id())
    LAS unsigned char* lds = (LAS unsigned char*)lds_raw;
#define GRID_SYNC() do { KARGS(kb_); xcd_barrier((unsigned*)(kb_->ws + WS_CTL), MK_TID() == 0); } while (0)
#define PHASE_IDS() int tid = MK_TID(); asm volatile("" : "+v"(tid)); const int lane = tid & 63, wave = __builtin_amdgcn_readfirstlane(tid >> 6); (void)lane; (void)wave
    int l_lo, l_hi, pmask;
    { KARGS(ka); l_lo = ka->l_lo; l_hi = ka->l_hi; pmask = ka->pmask; }
    { KARGS(ka); if (MK_TID() == 0) (void)xb_add((unsigned*)(ka->ws + WS_CTL) + XB_XCNT(xb_xcc_id()), 1u);
      if (ka->pmask == 0x7fffffff) cg::this_grid().sync(); }

#if defined(MK_XSYNC)
    for (int xs = 0; xs < MK_XSYNC; ++xs) GRID_SYNC();
#endif
    for (int l = l_lo; l < l_hi; ++l) {
        for (int rep_ = 0; rep_ < ((MK_DBL & PH_PREP) ? 2 : 1); ++rep_)
        if ((MK_EN & PH_PREP) && (pmask & PH_PREP)) {
            KARGS(ka); unsigned char* ws = ka->ws; PHASE_IDS();
            const int G = gridDim.x, gw = blockIdx.x * 8 + wave, NGW = G * 8;
            LAS float* scr = (LAS float*)(lds + wave * 16384);
            const float* w_in = ka->in[2] + (size_t)l * DMODEL * NIN;
            const float* w_br = ka->in[4] + (size_t)l * 3 * 512 * 1024;
            const float* w_out = ka->in[5] + (size_t)l * 1024 * 1024;
            const float* w_ff1 = ka->in[7] + (size_t)l * DMODEL * DFF;
            const float* w_ff2 = ka->in[8] + (size_t)l * DFF * DMODEL;
            bf16_t* WIN = (bf16_t*)(ws + WS_W + WO_IN); bf16_t* WGATE = (bf16_t*)(ws + WS_W + WO_GATE); bf16_t* WBR = (bf16_t*)(ws + WS_W + WO_BR);
            bf16_t* WOUT = (bf16_t*)(ws + WS_W + WO_OUT); bf16_t* WFF1 = (bf16_t*)(ws + WS_W + WO_FF1); bf16_t* WFF2 = (bf16_t*)(ws + WS_W + WO_FF2);
            constexpr int I_IN = 16 * (NPERM / 32), I_GATE = 16 * (3072 / 32), I_BR = 8 * 32, I_OUT = 16 * 32, I_FF1 = 16 * 128, I_FF2 = 64 * 32;
            constexpr int NITEMS = I_IN + I_GATE + 3 * I_BR + I_OUT + I_FF1 + I_FF2;
            {
                float va[32], vb[32];
                int it0 = gw;
                tr_load(tr_decode(it0 < NITEMS ? it0 : NITEMS - 1, lane, w_in, w_br, w_out, w_ff1, w_ff2, ws), va, lane);
                for (; it0 < NITEMS; it0 += 2 * NGW) {
                    const int it1 = it0 + NGW, it2 = it0 + 2 * NGW;
                    tr_load(tr_decode(it1 < NITEMS ? it1 : NITEMS - 1, lane, w_in, w_br, w_out, w_ff1, w_ff2, ws), vb, lane);
                    tr_store(tr_decode(it0, lane, w_in, w_br, w_out, w_ff1, w_ff2, ws), va, scr, lane);
                    tr_load(tr_decode(it2 < NITEMS ? it2 : NITEMS - 1, lane, w_in, w_br, w_out, w_ff1, w_ff2, ws), va, lane);
                    if (it1 < NITEMS) tr_store(tr_decode(it1, lane, w_in, w_br, w_out, w_ff1, w_ff2, ws), vb, scr, lane);
                }
            }
            if (l == 0) {
                float* COS = (float*)(ws + WS_COS); float* SIN = (float*)(ws + WS_SIN);
                float* SSQ = (float*)(ws + WS_SSQ); bf16_t* XG = (bf16_t*)(ws + WS_XG);
                for (int i = blockIdx.x * 512 + tid; i < SEQ * 32; i += G * 512) sincos_tab(i, COS, SIN);
                const float* g1 = ka->in[1]; const float* x = ka->in[0];
                const float4* gr = (const float4*)g1;
                float4 gg[4];
#pragma unroll
                for (int j = 0; j < 4; ++j) gg[j] = gr[lane + 64 * j];
                for (int m0 = gw; m0 < M; m0 += 4 * NGW) {
                    float4 v[4][4];
#pragma unroll
                    for (int r = 0; r < 4; ++r) { const int m = (m0 + r * NGW < M) ? m0 + r * NGW : m0; const float4* xr = (const float4*)(x + (size_t)m * DMODEL);
#pragma unroll
                        for (int j = 0; j < 4; ++j) v[r][j] = xr[lane + 64 * j]; }
#pragma unroll
                    for (int r = 0; r < 4; ++r) { const int m = m0 + r * NGW; if (m < M) {
                        float s = 0.f;
#pragma unroll
                        for (int j = 0; j < 4; ++j) {
                            const float4 w = v[r][j];
                            s += (w.x * w.x + w.y * w.y) + (w.z * w.z + w.w * w.w);
                            u32x2 o; o.x = pk2(w.x * gg[j].x, w.y * gg[j].y); o.y = pk2(w.z * gg[j].z, w.w * gg[j].w);
                            *(u32x2*)(XG + (size_t)m * DMODEL + 4 * (lane + 64 * j)) = o;
                        }
                        s = wave_sum_l(s, lane);
                        if (lane < 16) SSQ[(size_t)m * 16 + lane] = (lane == 0) ? s : 0.f;
                    } }
                }
            }
            GRID_SYNC();
        }
        for (int rep_ = 0; rep_ < ((MK_DBL & PH_P1) ? 2 : 1); ++rep_)
        if ((MK_EN & PH_P1) && (pmask & PH_P1)) {
            KARGS(ka); unsigned char* ws = ka->ws;
            pg8::Gemm g{(const bf16_t*)(ws + WS_XG), (const bf16_t*)(ws + WS_W + WO_IN), M, NPERM, DMODEL}; pg8::StaticOrder S; S.init(M, NPERM, (int)gridDim.x, (int)blockIdx.x);
            fill_rstd_table(S, (const float*)(ws + WS_SSQ), lds, MK_TID());
            EpiProjMK E{(const LAS float*)(lds + RSTD_TAB_OFF), ws, (const float*)(ws + WS_COS), (const float*)(ws + WS_SIN)};
            pg8::gemm_phase<EpiProjMK, pg8::StaticOrder, true, true>(lds, g, S, E, MK_TID());
            GRID_SYNC();
        }
        if ((MK_EN & PH_ATT1) && (pmask & PH_ATT1)) {
            KARGS(ka); unsigned char* ws = ka->ws; PHASE_IDS();
            const int G = gridDim.x, gw = blockIdx.x * 8 + wave, NGW = G * 8;
            {
                const bf16_t* CK = (const bf16_t*)(ws + WS_CK); float* KM = (float*)(ws + WS_KMEAN);
                LAS float* red = (LAS float*)lds;
                for (int it = blockIdx.x; it < 512; it += G) {
                    const int blk = it & 31, h = (it >> 5) & 7, b = it >> 8;
                    const bf16_t* p = CK + ((size_t)b * SEQ + blk * 256 + wave * 32 + (lane >> 3)) * 512 + h * 64 + (lane & 7) * 8;
                    float a[8];
#pragma unroll
                    for (int e = 0; e < 8; ++e) a[e] = 0.f;
#pragma unroll
                    for (int r = 0; r < 4; ++r) {
                        const u32x4 v = *(const u32x4*)(p + (size_t)r * 8 * 512);
                        a[0] += bflo(v.x); a[1] += bfhi(v.x); a[2] += bflo(v.y); a[3] += bfhi(v.y); a[4] += bflo(v.z); a[5] += bfhi(v.z); a[6] += bflo(v.w); a[7] += bfhi(v.w);
                    }
#pragma unroll
                    for (int e = 0; e < 8; ++e) { a[e] += bperm_xor(a[e], lane, 8); a[e] += bperm_xor(a[e], lane, 16); a[e] += bperm_xor(a[e], lane, 32); }
                    if (lane < 8) {
#pragma unroll
                        for (int e = 0; e < 8; ++e) red[wave * 64 + lane * 8 + e] = a[e];
                    }
                    asm volatile("s_waitcnt lgkmcnt(0)" ::: "memory"); __builtin_amdgcn_s_barrier();
                    if (tid < 64) { float s = 0.f;
#pragma unroll
                        for (int w8 = 0; w8 < 8; ++w8) s += red[w8 * 64 + tid];
                        KM[it * 64 + tid] = s * (1.0f / 256.0f); }
                    asm volatile("s_waitcnt lgkmcnt(0)" ::: "memory"); __builtin_amdgcn_s_barrier();
                }
            }
#if MK_DSA
            {
                const bf16_t* IQ = (const bf16_t*)(ws + WS_IQ); const bf16_t* IK = (const bf16_t*)(ws + WS_IK); const float* IW = (const float*)(ws + WS_IW);
                bf16_t* AQ = (bf16_t*)(ws + WS_AQ); const bf16_t* AK = (const bf16_t*)(ws + WS_AK); const bf16_t* AV = (const bf16_t*)(ws + WS_AV);
                dsa::lds_u8* wl = (dsa::lds_u8*)lds + wave * dsa::WAVE_LDS;
                dsa::lds_u8* stg = (dsa::lds_u8*)lds + dsa::OFF_STG;
#pragma unroll 1
                for (int i2 = 2 * (int)blockIdx.x; i2 < 512; i2 += 2 * G) {
#pragma unroll 1
                    for (int k = 0; k < ((MK_DBL & DBL_DSA) ? 4 : 2); ++k) {
                        int bb = k & 1, QQ = (k & 1) ? 32 * (255 - (i2 >> 1)) : 32 * (i2 >> 1);
                        asm volatile("" : "+s"(bb), "+s"(QQ));
                        bf16_t* OO = ((MK_DBL & DBL_DSA) && k < 2) ? (bf16_t*)(ws + WS_DUMMY) : AQ;
                        dsa::group(bb, QQ + 4 * wave, IQ, IK, IW, AQ, OO, AK, AV, wl, stg, QQ, tid, lane);
                    }
                }
                __syncthreads();
            }
#endif
            {
                const int bx = blockIdx.x, v = (G % 8 == 0) ? (bx % 8) * (G / 8) + bx / 8 : bx;
                const attn_body::bf16* BQ = (const attn_body::bf16*)(ws + WS_BQ); const attn_body::bf16* BK = (const attn_body::bf16*)(ws + WS_BK); const attn_body::bf16* BV = (const attn_body::bf16*)(ws + WS_BV);
                const float* sinks = ka->in[3] + l * 8;
                for (int rep_ = 0; rep_ < ((MK_DBL & DBL_SWA) ? 2 : 1); ++rep_)
                for (int i = v; i < 512; i += G) {
                    const int qb = i & 31, bh = i >> 5, h = bh & 7, b = bh >> 3;
                    attn_body::bf16* OO = (attn_body::bf16*)(ws + (((MK_DBL & DBL_SWA) && rep_ == 0) ? WS_DUMMY : WS_BQ));
                    attn_body::attn_unit<8, 1, 512, 128>(b, qb, h * 64, (h >> 2) * 64, BQ, BK, BV, OO, (const LAS float*)nullptr, sinks[h] * LOG2E, (char*)lds_raw, MK_TID());
                }
            }
            GRID_SYNC();
        }
        if ((MK_EN & PH_ATT2) && (pmask & PH_ATT2)) {
            KARGS(ka); unsigned char* ws = ka->ws;
            const int G = gridDim.x, bx = blockIdx.x, v = (G % 8 == 0) ? (bx % 8) * (G / 8) + bx / 8 : bx;
            const attn_body::bf16* CQ = (const attn_body::bf16*)(ws + WS_CQ); const attn_body::bf16* CK = (const attn_body::bf16*)(ws + WS_CK); const attn_body::bf16* CV = (const attn_body::bf16*)(ws + WS_CV);
            const float* KM = (const float*)(ws + WS_KMEAN);
            for (int rep_ = 0; rep_ < ((MK_DBL & PH_ATT2) ? 2 : 1); ++rep_)
            for (int i = v; i < 256; i += G) {
                const int s = i & 15, bh = i >> 4, h = bh & 7, b = bh >> 3;
                attn_body::bf16* OO = (attn_body::bf16*)(ws + (((MK_DBL & PH_ATT2) && rep_ == 0) ? WS_DUMMY : WS_CQ));
                LAS float* kml = (LAS float*)(lds + 98304);
                { const int t_ = MK_TID(); *(LAS f32x4*)(kml + 4 * t_) = *(const f32x4*)(KM + (size_t)bh * 2048 + 4 * t_); asm volatile("s_waitcnt vmcnt(0) lgkmcnt(0)" ::: "memory"); __builtin_amdgcn_s_barrier(); }
#pragma unroll 1
                for (int k = 0; k < 2; ++k) {
                    const int qb = k ? 31 - s : s;
                    attn_body::attn_unit<8, 0, 512, 512>(b, qb, h * 64, h * 64, CQ, CK, CV, OO, (const LAS float*)kml, 0.f, (char*)lds_raw, MK_TID());
                }
            }
            GRID_SYNC();
        }
        for (int rep_ = 0; rep_ < ((MK_DBL & PH_GATE) ? 2 : 1); ++rep_)
        if ((MK_EN & PH_GATE) && (pmask & PH_GATE)) {
            KARGS(ka); unsigned char* ws = ka->ws;
            pg8::Gemm g{(const bf16_t*)(ws + WS_XG), (const bf16_t*)(ws + WS_W + WO_GATE), M, 3072, DMODEL}; pg8::StaticOrder S; S.init(M, 3072, (int)gridDim.x, (int)blockIdx.x);
            fill_rstd_table(S, (const float*)(ws + WS_SSQ), lds, MK_TID());
            EpiActMK<0> E{(const LAS float*)(lds + RSTD_TAB_OFF), (bf16_t*)(ws + WS_GS), 3072};
            pg8::gemm_phase<EpiActMK<0>, pg8::StaticOrder, true, true>(lds, g, S, E, MK_TID());
            GRID_SYNC();
        }
        for (int rep_ = 0; rep_ < ((MK_DBL & PH_BRANCH) ? 2 : 1); ++rep_)
        if ((MK_EN & PH_BRANCH) && (pmask & PH_BRANCH)) {
            {
                KARGS(ka); unsigned char* ws = ka->ws;
                static_assert(WS_BQ - WS_AQ == (size_t)M * 512 * 2 && WS_CQ - WS_BQ == (size_t)M * 512 * 2, "O_a | O_b | O_c contiguous");
                pg8::Gemm g{(const bf16_t*)(ws + WS_AQ), (const bf16_t*)(ws + WS_W + WO_BR), 3 * M, 3 * 1024, 512};
                BranchOrder S; S.S.init(M, 1024, (int)gridDim.x, (int)blockIdx.x);
                EpiBranchMK E{(const bf16_t*)(ws + WS_GS), (bf16_t*)(ws + WS_MG)};
                pg8::gemm_phase<EpiBranchMK, BranchOrder, true, true>(lds, g, S, E, MK_TID());
            }
            GRID_SYNC();
        }
        if ((MK_EN & PH_OUT) && (pmask & PH_OUT)) {
            KARGS(ka); unsigned char* ws = ka->ws;
            pg8::Gemm g{(const bf16_t*)(ws + WS_MG), (const bf16_t*)(ws + WS_W + WO_OUT), M, 1024, 1024}; pg8::StaticOrder S; S.init(M, 1024, (int)gridDim.x, (int)blockIdx.x);
            EpiResMK E{(l == 0) ? ka->in[0] : (const float*)ka->out, ka->out, ka->in[6] + (size_t)l * DMODEL, (bf16_t*)(ws + WS_XG), (float*)(ws + WS_SSQ)};
            pg8::gemm_phase<EpiResMK, pg8::StaticOrder, true, true>(lds, g, S, E, MK_TID());
            GRID_SYNC();
        }
        for (int rep_ = 0; rep_ < ((MK_DBL & PH_FF1) ? 2 : 1); ++rep_)
        if ((MK_EN & PH_FF1) && (pmask & PH_FF1)) {
            KARGS(ka); unsigned char* ws = ka->ws;
            pg8::Gemm g{(const bf16_t*)(ws + WS_XG), (const bf16_t*)(ws + WS_W + WO_FF1), M, DFF, DMODEL}; pg8::StaticOrder S; S.init(M, DFF, (int)gridDim.x, (int)blockIdx.x);
            fill_rstd_table(S, (const float*)(ws + WS_SSQ), lds, MK_TID());
            EpiActMK<1> E{(const LAS float*)(lds + RSTD_TAB_OFF), (bf16_t*)(ws + WS_U), DFF};
            pg8::gemm_phase<EpiActMK<1>, pg8::StaticOrder, true, true>(lds, g, S, E, MK_TID());
            GRID_SYNC();
        }
        if ((MK_EN & PH_FF2) && (pmask & PH_FF2)) {
            KARGS(ka); unsigned char* ws = ka->ws;
            pg8::Gemm g{(const bf16_t*)(ws + WS_U), (const bf16_t*)(ws + WS_W + WO_FF2), M, 1024, DFF}; pg8::StaticOrder S; S.init(M, 1024, (int)gridDim.x, (int)blockIdx.x);
            EpiResMK E{(const float*)ka->out, ka->out, (l + 1 < 2) ? ka->in[1] + (size_t)(l + 1) * DMODEL : nullptr, (bf16_t*)(ws + WS_XG), (float*)(ws + WS_SSQ)};
            pg8::gemm_phase<EpiResMK, pg8::StaticOrder, true, true>(lds, g, S, E, MK_TID());
            GRID_SYNC();
        }
    }
    {
        KARGS(ka);
        if (ka->fin) {
            PHASE_IDS();
            const int gw = blockIdx.x * 8 + wave, NGW = gridDim.x * 8;
            float* out = ka->out; const float* SSQ = (const float*)(ka->ws + WS_SSQ);
            const float4* gr = (const float4*)ka->in[9];
            float4 gg[4];
#pragma unroll
            for (int j = 0; j < 4; ++j) gg[j] = gr[lane + 64 * j];
            for (int m0 = gw; m0 < M; m0 += 2 * NGW) {
                float4 v[2][4]; float r2[2];
#pragma unroll
                for (int r = 0; r < 2; ++r) { const int m = (m0 + r * NGW < M) ? m0 + r * NGW : m0; const float4* xr = (const float4*)(out + (size_t)m * DMODEL); r2[r] = rstd_of(SSQ, m);
#pragma unroll
                    for (int j = 0; j < 4; ++j) v[r][j] = xr[lane + 64 * j]; }
#pragma unroll
                for (int r = 0; r < 2; ++r) { const int m = m0 + r * NGW; if (m < M) { float4* xr = (float4*)(out + (size_t)m * DMODEL);
#pragma unroll
                    for (int j = 0; j < 4; ++j) { float4 w = v[r][j]; const float q = r2[r]; w.x *= q * gg[j].x; w.y *= q * gg[j].y; w.z *= q * gg[j].z; w.w *= q * gg[j].w; xr[lane + 64 * j] = w; } } }
            }
        }
    }
}

extern "C" void kernel_launch(void* const* d_in, const int* in_sizes, int n_in, void* d_out, int out_size, void* d_ws, size_t ws_size, hipStream_t stream) {
    const float* x = (const float*)d_in[0];
    const float* norm1 = (const float*)d_in[1];
    const float* w_in = (const float*)d_in[2];
    const float* sinks = (const float*)d_in[3];
    const float* w_branch = (const float*)d_in[4];
    const float* w_out = (const float*)d_in[5];
    const float* norm2 = (const float*)d_in[6];
    const float* w_ff1 = (const float*)d_in[7];
    const float* w_ff2 = (const float*)d_in[8];
    const float* norm_f = (const float*)d_in[9];
    float* out = (float*)d_out;
    unsigned char* ws = (unsigned char*)d_ws;
    float* SSQ = (float*)(ws + WS_SSQ); float* IW = (float*)(ws + WS_IW); float* KMEAN = (float*)(ws + WS_KMEAN);
    float* COS = (float*)(ws + WS_COS); float* SIN = (float*)(ws + WS_SIN);
    bf16_t* XG = (bf16_t*)(ws + WS_XG);
    bf16_t *AQ = (bf16_t*)(ws + WS_AQ), *BQ = (bf16_t*)(ws + WS_BQ), *CQ = (bf16_t*)(ws + WS_CQ);
    bf16_t *AK = (bf16_t*)(ws + WS_AK), *AV = (bf16_t*)(ws + WS_AV), *IQ = (bf16_t*)(ws + WS_IQ), *IK = (bf16_t*)(ws + WS_IK);
    bf16_t *BK = (bf16_t*)(ws + WS_BK), *BV = (bf16_t*)(ws + WS_BV), *CK = (bf16_t*)(ws + WS_CK), *CV = (bf16_t*)(ws + WS_CV);
    bf16_t *GS = (bf16_t*)(ws + WS_GS), *MG = (bf16_t*)(ws + WS_MG), *U = (bf16_t*)(ws + WS_U);
    unsigned short* SEL = (unsigned short*)(ws + WS_SEL);
    (void)w_in; (void)w_branch; (void)w_out; (void)w_ff1; (void)w_ff2; (void)norm1; (void)norm2; (void)norm_f; (void)x; (void)XG; (void)SSQ; (void)GS; (void)MG; (void)U; (void)COS; (void)SIN; (void)IW;

    static int grid = 0;
    if (grid == 0) {
        int dev = 0, cus = 0, per_cu = 0;
        hipGetDevice(&dev);
        hipDeviceGetAttribute(&cus, hipDeviceAttributeMultiprocessorCount, dev);
        hipFuncSetAttribute((const void*)mk_fwd, hipFuncAttributeMaxDynamicSharedMemorySize, MK_LDS);
        hipOccupancyMaxActiveBlocksPerMultiprocessor(&per_cu, (const void*)mk_fwd, 512, MK_LDS);
        if (per_cu < 1) per_cu = 1;
        grid = cus;
        (void)hipGetLastError();
    }
    auto launch_mk = [&](int l_lo, int l_hi, int pmask, int fin) {
        MKArgs a{};
        for (int i = 0; i < 10; ++i) a.in[i] = (const float*)d_in[i];
        a.out = out; a.ws = ws; a.l_lo = l_lo; a.l_hi = l_hi; a.pmask = pmask; a.fin = fin;
        void* args[] = {&a};
        hipMemsetAsync(ws + WS_CTL, 0, CTL_ZERO_BYTES, stream);
        hipLaunchCooperativeKernel((const void*)mk_fwd, dim3(grid), dim3(512), args, MK_LDS, stream);
    };
    launch_mk(0, 2, 0x1ff, 1);
}
```

```cpp
#include <hip/hip_runtime.h>
#include <stdint.h>

typedef unsigned short bf16_t;
#define DEVI __device__ __forceinline__

constexpr int BATCH = 2, SEQ = 8192, DMODEL = 1024, M = BATCH * SEQ, NIN = 6340, DFF = 4096;
constexpr int NPROJ = 3268;
constexpr float EPS = 1e-6f;
constexpr float C2 = 0.125f * 1.4426950408889634f;
constexpr float LOG2E = 1.4426950408889634f;

constexpr size_t MiB = 1u << 20;
constexpr size_t WS_CTL = 0;
constexpr size_t WS_SSQ = 1 * MiB;
constexpr size_t WS_IW = 2 * MiB;
constexpr size_t WS_KMEAN = 2 * MiB + 512 * 1024;
constexpr size_t WS_COS = 3 * MiB, WS_SIN = 4 * MiB;
constexpr size_t WS_W = 6 * MiB;
constexpr size_t WS_XG = 40 * MiB;
constexpr size_t WS_AQ = 72 * MiB, WS_BQ = 88 * MiB, WS_CQ = 104 * MiB;
constexpr size_t WS_AK = 120 * MiB, WS_AV = 122 * MiB, WS_IQ = 124 * MiB, WS_IK = 132 * MiB;
constexpr size_t WS_BK = 134 * MiB, WS_BV = 138 * MiB, WS_CK = 142 * MiB, WS_CV = 158 * MiB;
constexpr size_t WS_GS = 174 * MiB;
constexpr size_t WS_MG = 222 * MiB;
constexpr size_t WS_U = 120 * MiB;
constexpr size_t WS_SEL = 248 * MiB;

DEVI float bf2f(bf16_t v) { return __uint_as_float((unsigned)v << 16); }
DEVI bf16_t f2bf(float f) { unsigned u = __float_as_uint(f); return (bf16_t)((u + 0x7fffu + ((u >> 16) & 1u)) >> 16); }
DEVI float wave_sum(float v) {
#pragma unroll
    for (int o = 1; o < 64; o <<= 1) v += __shfl_xor(v, o);
    return v;
}
DEVI float wave_max(float v) {
#pragma unroll
    for (int o = 1; o < 64; o <<= 1) v = fmaxf(v, __shfl_xor(v, o));
    return v;
}
DEVI float rstd_of(const float* ssq, int m) {
    const float4* p = (const float4*)(ssq + (size_t)m * 16);
    float4 a = p[0], b = p[1], c = p[2], d = p[3];
    float s = ((a.x + a.y) + (a.z + a.w)) + ((b.x + b.y) + (b.z + b.w)) + ((c.x + c.y) + (c.z + c.w)) + ((d.x + d.y) + (d.z + d.w));
    return rsqrtf(s * (1.0f / DMODEL) + EPS);
}

__device__ const double INVF[32] = {
    1.00000000000000000e+00, 7.49894209332455874e-01, 5.62341325190349073e-01, 4.21696503428582226e-01,
    3.16227766016837941e-01, 2.37137370566165517e-01, 1.77827941003892293e-01, 1.33352143216332403e-01,
    1.00000000000000006e-01, 7.49894209332455791e-02, 5.62341325190349114e-02, 4.21696503428582239e-02,
    3.16227766016837913e-02, 2.37137370566165538e-02, 1.77827941003892293e-02, 1.33352143216332406e-02,
    1.00000000000000002e-02, 7.49894209332455791e-03, 5.62341325190349097e-03, 4.21696503428582292e-03,
    3.16227766016837939e-03, 2.37137370566165538e-03, 1.77827941003892275e-03, 1.33352143216332406e-03,
    1.00000000000000002e-03, 7.49894209332455856e-04, 5.62341325190349097e-04, 4.21696503428582237e-04,
    3.16227766016837939e-04, 2.37137370566165538e-04, 1.77827941003892270e-04, 1.33352143216332395e-04};

DEVI void sincos_tab(int idx, float* cs, float* sn) {
    const int pos = idx >> 5, f = idx & 31;
    double a = (double)pos * INVF[f];
    const double TWO_PI = 6.283185307179586476925286766559;
    double k = rint(a / TWO_PI);
    double r = a - k * TWO_PI;
    double r2 = r * r;
    double s = 0.0, c = 0.0, ts = r, tc = 1.0;
#pragma unroll 1
    for (int n = 0; n < 16; ++n) {
        c += tc; s += ts;
        tc = -tc * r2 / (double)((2 * n + 1) * (2 * n + 2));
        ts = -ts * r2 / (double)((2 * n + 2) * (2 * n + 3));
    }
    cs[idx] = (float)c; sn[idx] = (float)s;
}

#if defined(PG8_STAMP)
#if PG8_USE_SHADERCLK
#define PG8_CLK() ((unsigned long long)__builtin_readcyclecounter())
#else
#define PG8_CLK() ((unsigned long long)__builtin_amdgcn_s_memrealtime())
#endif
#endif
namespace pg8 {
#define PG8_LAS __attribute__((address_space(3)))
typedef unsigned short bf16_t;
typedef short bf16x8 __attribute__((ext_vector_type(8)));
typedef float f32x4 __attribute__((ext_vector_type(4)));
typedef unsigned u32x4 __attribute__((ext_vector_type(4)));
constexpr int BM = 256, BK = 64, HALF = 128, HTB = HALF * BK * 2  , STAGE_BYTES = 8 * HTB, NXCD = 8, WGM = 8;

__host__ __device__ __forceinline__ int lds_byte(int r, int c) { const int st = (r >> 4) * 2 + (c >> 5), rr = r & 15, cc = c & 31, ob = rr * 64 + cc * 2; return st * 1024 + (ob ^ (((ob >> 9) & 1) << 5)); }
__host__ __device__ __forceinline__ void stage_rc(int b, int& R, int& C) { const int st = b / 1024, sb = b % 1024, swz = sb ^ (((sb >> 9) & 1) << 5); R = (st >> 1) * 16 + swz / 64; C = (st & 1) * 32 + (swz % 64) / 2; }
__host__ __device__ __forceinline__ int perm32(int rho) { const int n = rho >> 4, i = rho & 15; return 8 * (i >> 2) + 4 * n + (i & 3); }

struct Unit { int pm, pn, ord; };
struct Gemm { const bf16_t* A; const bf16_t* Bt; int M, N, K; };

struct StaticOrder {
    int nM, nN, nwg, G, c;
    __host__ __device__ void init(int M, int N, int G_, int c_) { nM = M / BM; nN = N / BM; nwg = nM * nN; G = G_; c = c_; }
    __host__ __device__ bool next(int i, Unit& u) const {
        const long L = (long)i * G + c; if (L >= nwg) return false;
        int wgid = (int)L; { const int q = nwg / NXCD, r = nwg % NXCD, xcd = wgid % NXCD, off = wgid / NXCD; wgid = (xcd < r ? xcd * (q + 1) : r * (q + 1) + (xcd - r) * q) + off; }
        const int nig = WGM * nN, gid = wgid / nig, fm = gid * WGM, gsz = (nM - fm) < WGM ? (nM - fm) : WGM;
        u.pm = fm + ((wgid % nig) % gsz); u.pn = (wgid % nig) / gsz; u.ord = i; return true;
    }
    __device__ __forceinline__ void a_ready(const Unit&) const {}
    __device__ __forceinline__ void done(const Unit&) const {}
};

__device__ __forceinline__ unsigned cvt_pk_bf16(float lo, float hi) { unsigned r; asm volatile("v_cvt_pk_bf16_f32 %0, %1, %2" : "=v"(r) : "v"(lo), "v"(hi)); return r; }
typedef float f32x2 __attribute__((ext_vector_type(2)));
template <class Epi, class Sched, bool ALIGN_EPI = false, bool SP2 = false>
__device__ __forceinline__ void gemm_phase(PG8_LAS unsigned char* lds, const Gemm g, const Sched& S, const Epi& E, int tid_in, unsigned long long* g_probe_acc = nullptr) {
    int tid_l = tid_in; asm volatile("" : "+v"(tid_l));
    const int tid = tid_l, wid = __builtin_amdgcn_readfirstlane(tid >> 6), lane = tid & 63, wr = wid >> 2, wc = wid & 3, fr = lane & 15, fq = lane >> 4;
    const int K = g.K, nt = K / BK;
    unsigned voffA[2], voffB[2];
#pragma unroll
    for (int i = 0; i < 2; ++i) { int R, C; stage_rc(tid * 16 + i * 8192, R, C); const int Rb = Epi::PERM ? ((R & ~31) + perm32(R & 31)) : R;
        voffA[i] = (unsigned)(R * K + C) * 2u; voffB[i] = (unsigned)(Rb * K + C) * 2u; }
    const size_t kstep = (size_t)(BK * 2);
    const size_t hstep = (size_t)HALF * K * 2;
    const size_t tstep = 2 * hstep;
    const unsigned ldsw = (unsigned)wid * 1024u;
    const int aoff = lds_byte(wr * 64 + fr, fq * 8), boff = lds_byte(wc * 32 + fr, fq * 8);
#define PG8_SA(b, h) (((b) * 2 + (h)) * HTB)
#define PG8_SB(b, h) ((4 + (b) * 2 + (h)) * HTB)
#define PG8_STAGE(bufoff, gbase, voff) do { _Pragma("unroll") for (int _i = 0; _i < 2; ++_i) \
        __builtin_amdgcn_global_load_lds((const unsigned*)((const char*)(gbase) + (voff)[_i]), (PG8_LAS unsigned*)(lds + (bufoff) + ldsw + _i * 8192), 16, 0, 0); } while (0)
#define PG8_LDA(dst, b, h) do { _Pragma("unroll") for (int m = 0; m < 4; ++m) _Pragma("unroll") for (int k = 0; k < 2; ++k) dst[m][k] = *(const PG8_LAS bf16x8*)(lds + PG8_SA(b, h) + aoff + m * 2048 + k * 1024); } while (0)
#define PG8_LDB(dst, b, h) do { _Pragma("unroll") for (int n = 0; n < 2; ++n) _Pragma("unroll") for (int k = 0; k < 2; ++k) dst[n][k] = *(const PG8_LAS bf16x8*)(lds + PG8_SB(b, h) + boff + n * 2048 + k * 1024); } while (0)
#define PG8_MMA(ai, bj, At, Bt) do { __builtin_amdgcn_s_setprio(1); _Pragma("unroll") for (int m = 0; m < 4; ++m) _Pragma("unroll") for (int n = 0; n < 2; ++n) _Pragma("unroll") for (int k = 0; k < 2; ++k) \
        acc[ai][bj][m][n] = __builtin_amdgcn_mfma_f32_16x16x32_bf16(Bt[n][k], At[m][k], acc[ai][bj][m][n], 0, 0, 0); __builtin_amdgcn_s_setprio(0); } while (0)
#define PG8_WAIT_V(n) asm volatile("s_waitcnt vmcnt(" #n ")" ::: "memory")
#define PG8_WAIT_L(n) asm volatile("s_waitcnt lgkmcnt(" #n ")" ::: "memory")
#define PG8_BAR __builtin_amdgcn_s_barrier()
#define PG8_SCHED __builtin_amdgcn_sched_barrier(0)
    Unit cur, nxt; int ui = 0;
    if (!S.next(0, cur)) return;
    f32x4 acc[2][2][4][2];
#pragma unroll
    for (int a = 0; a < 2; ++a)
#pragma unroll
        for (int b = 0; b < 2; ++b)
#pragma unroll
            for (int m = 0; m < 4; ++m)
#pragma unroll
                for (int n = 0; n < 2; ++n) acc[a][b][m][n] = (f32x4){0.f, 0.f, 0.f, 0.f};
    bf16x8 At[4][2], B0[2][2], B1[2][2];
    const char* cA = (const char*)g.A + (size_t)cur.pm * tstep; const char* cB = (const char*)g.Bt + (size_t)cur.pn * tstep;
    S.a_ready(cur);
    if constexpr (SP2) {
        PG8_STAGE(PG8_SB(0, 0), cB, voffB); PG8_STAGE(PG8_SB(0, 1), cB + hstep, voffB); PG8_STAGE(PG8_SA(0, 0), cA, voffA); PG8_STAGE(PG8_SA(0, 1), cA + hstep, voffA);
        if (wr == 1) PG8_BAR;
        PG8_WAIT_V(2); PG8_BAR;
        PG8_STAGE(PG8_SB(1, 0), cB + kstep, voffB); PG8_STAGE(PG8_SA(1, 0), cA + kstep, voffA); PG8_STAGE(PG8_SB(1, 1), cB + hstep + kstep, voffB);
        PG8_WAIT_V(6); PG8_BAR;
    } else {
        PG8_STAGE(PG8_SB(0, 0), cB, voffB); PG8_STAGE(PG8_SA(0, 0), cA, voffA); PG8_STAGE(PG8_SB(0, 1), cB + hstep, voffB); PG8_STAGE(PG8_SA(0, 1), cA + hstep, voffA);
        if (wr == 1) PG8_BAR;
        PG8_WAIT_V(4); PG8_BAR;
        PG8_STAGE(PG8_SB(1, 0), cB + kstep, voffB); PG8_STAGE(PG8_SA(1, 0), cA + kstep, voffA); PG8_STAGE(PG8_SB(1, 1), cB + hstep + kstep, voffB);
        PG8_WAIT_V(6); PG8_BAR;
    }
    for (;;) {
        const bool has_next = S.next(ui + 1, nxt);
        const char* nA = has_next ? (const char*)g.A + (size_t)nxt.pm * tstep : cA; const char* nB = has_next ? (const char*)g.Bt + (size_t)nxt.pn * tstep : cB;
#if defined(PG8_STAMP)
        unsigned long long st0_ = 0; if constexpr (Epi::PROBE_DBL) { if (blockIdx.x == PG8_STAMP_BLK && wid == PG8_STAMP_WAVE) st0_ = PG8_CLK(); }
#endif
        for (int t = 0; t < nt; t += 2) {
            const bool last = (t == nt - 2);
            const char* a1 = cA + (size_t)(t + 1) * kstep;
            const char* a2 = last ? nA : cA + (size_t)(t + 2) * kstep; const char* b2 = last ? nB : cB + (size_t)(t + 2) * kstep;
            const char* a3 = a2 + kstep; const char* b3 = b2 + kstep;
            if (last && has_next) S.a_ready(nxt);
            if constexpr (SP2) {
            PG8_LDB(B0, 0, 0); PG8_LDB(B1, 0, 1); PG8_SCHED; PG8_LDA(At, 0, 0); PG8_STAGE(PG8_SA(1, 1), a1 + hstep, voffA);
            PG8_WAIT_V(8); PG8_WAIT_L(0); PG8_BAR; PG8_MMA(0, 0, At, B0); PG8_MMA(0, 1, At, B1); PG8_BAR; PG8_SCHED;
            PG8_LDA(At, 0, 1); PG8_STAGE(PG8_SB(0, 0), b2, voffB); PG8_STAGE(PG8_SB(0, 1), b2 + hstep, voffB); PG8_STAGE(PG8_SA(0, 0), a2, voffA);
            PG8_WAIT_V(8); PG8_WAIT_L(0); PG8_BAR; PG8_MMA(1, 0, At, B0); PG8_MMA(1, 1, At, B1); PG8_BAR; PG8_SCHED;
            PG8_LDB(B0, 1, 0); PG8_LDB(B1, 1, 1); PG8_SCHED; PG8_LDA(At, 1, 0); PG8_STAGE(PG8_SA(0, 1), a2 + hstep, voffA);
            PG8_WAIT_V(8); PG8_WAIT_L(0); PG8_BAR; PG8_MMA(0, 0, At, B0); PG8_MMA(0, 1, At, B1); PG8_BAR; PG8_SCHED;
            PG8_LDA(At, 1, 1); PG8_STAGE(PG8_SB(1, 0), b3, voffB); PG8_STAGE(PG8_SB(1, 1), b3 + hstep, voffB); PG8_STAGE(PG8_SA(1, 0), a3, voffA);
            PG8_WAIT_V(8); PG8_WAIT_L(0); PG8_BAR; PG8_MMA(1, 0, At, B0); PG8_MMA(1, 1, At, B1); PG8_BAR; PG8_SCHED;
            } else {
            PG8_LDB(B0, 0, 0); PG8_SCHED; PG8_LDA(At, 0, 0); PG8_STAGE(PG8_SA(1, 1), a1 + hstep, voffA);
            PG8_WAIT_L(8); PG8_BAR; PG8_WAIT_L(0); PG8_MMA(0, 0, At, B0); PG8_BAR; PG8_SCHED;
            PG8_LDB(B1, 0, 1); PG8_STAGE(PG8_SB(0, 0), b2, voffB);
            PG8_BAR; PG8_WAIT_L(0); PG8_MMA(0, 1, At, B1); PG8_BAR;
            PG8_LDA(At, 0, 1); PG8_STAGE(PG8_SA(0, 0), a2, voffA);
            PG8_BAR; PG8_WAIT_L(0); PG8_MMA(1, 0, At, B0); PG8_BAR; PG8_SCHED;
            PG8_STAGE(PG8_SB(0, 1), b2 + hstep, voffB);
            PG8_WAIT_V(6); PG8_BAR; PG8_MMA(1, 1, At, B1); PG8_BAR;
            PG8_LDB(B0, 1, 0); PG8_SCHED; PG8_LDA(At, 1, 0); PG8_STAGE(PG8_SA(0, 1), a2 + hstep, voffA);
            PG8_WAIT_L(8); PG8_BAR; PG8_WAIT_L(0); PG8_MMA(0, 0, At, B0); PG8_BAR; PG8_SCHED;
            PG8_LDB(B1, 1, 1); PG8_STAGE(PG8_SB(1, 0), b3, voffB);
            PG8_BAR; PG8_WAIT_L(0); PG8_MMA(0, 1, At, B1); PG8_BAR;
            PG8_LDA(At, 1, 1); PG8_STAGE(PG8_SA(1, 0), a3, voffA);
            PG8_BAR; PG8_WAIT_L(0); PG8_MMA(1, 0, At, B0); PG8_BAR; PG8_SCHED;
            PG8_STAGE(PG8_SB(1, 1), b3 + hstep, voffB);
            PG8_WAIT_V(6); PG8_BAR; PG8_MMA(1, 1, At, B1); PG8_BAR;
            }
        }
        if constexpr (ALIGN_EPI) { if (wr == 0) PG8_BAR; }
#if defined(PG8_STAMP)
        unsigned long long st1_ = 0; if constexpr (Epi::PROBE_DBL) { if (blockIdx.x == PG8_STAMP_BLK && wid == PG8_STAMP_WAVE) { st1_ = PG8_CLK(); if (PG8_STAMP == 1 && lane == 0) atomicAdd(g_probe_acc, (st1_ - st0_) >> PG8_SHIFT); } }
#endif
#if defined(PG8_DBL_EPI)
        if constexpr (Epi::PROBE_DBL) { E(acc, cur, wr, wc, fr, fq); asm volatile("" ::: "memory"); }
#endif
        if constexpr (!Epi::AFTER_DRAIN) { E(acc, cur, wr, wc, fr, fq); S.done(cur); }
#if defined(PG8_STAMP)
        if constexpr (Epi::PROBE_DBL) { if (blockIdx.x == PG8_STAMP_BLK && wid == PG8_STAMP_WAVE) { asm volatile("s_waitcnt vmcnt(0)" ::: "memory"); const unsigned long long st2_ = PG8_CLK(); if (PG8_STAMP == 2 && lane == 0) atomicAdd(g_probe_acc, (st2_ - st1_) >> PG8_SHIFT); } }
#endif
        if (!has_next) break;
#pragma unroll
        for (int a = 0; a < 2; ++a)
#pragma unroll
            for (int b = 0; b < 2; ++b)
#pragma unroll
                for (int m = 0; m < 4; ++m)
#pragma unroll
                    for (int n = 0; n < 2; ++n) acc[a][b][m][n] = (f32x4){0.f, 0.f, 0.f, 0.f};
        cur = nxt; cA = nA; cB = nB; ++ui;
        if constexpr (ALIGN_EPI) { if (wr == 1) PG8_BAR; }
    }
    PG8_WAIT_V(0);
    if constexpr (!ALIGN_EPI) { if (wr == 0) PG8_BAR; }
    PG8_BAR;
    if constexpr (Epi::AFTER_DRAIN) { E.fused(acc, cur, wr, wc, fr, fq, lds, wid, lane); S.done(cur); }
#undef PG8_SA
#undef PG8_SB
#undef PG8_STAGE
#undef PG8_LDA
#undef PG8_LDB
#undef PG8_MMA
#undef PG8_WAIT_V
#undef PG8_WAIT_L
#undef PG8_BAR
#undef PG8_SCHED
}
}

#include <hip/hip_bf16.h>
#include <cmath>
namespace attn_body {
using bf16=__hip_bfloat16;
using bf16x8=__attribute__((ext_vector_type(8)))short;
using s16x4=__attribute__((ext_vector_type(4)))short;
using f32x16=__attribute__((ext_vector_type(16)))float;
using u32x4=__attribute__((ext_vector_type(4)))unsigned;
typedef float f32x4 __attribute__((ext_vector_type(4)));
constexpr int SEQ=8192,D=64;
constexpr int NW=8,QBLK=32,QB=QBLK*NW,KVBLK=64,NQB=SEQ/QB;
__device__ __forceinline__ int crow(int r,int hi){return (r&3)+8*(r>>2)+4*hi;}
#define SBAR() __builtin_amdgcn_sched_barrier(0)
__device__ __forceinline__ void cmask(f32x16&p0,f32x16&p1,int jb,int qrel,int hi){
  const float NEG=-INFINITY; int kb=64*jb+4*hi;
  #pragma unroll
  for(int r=0;r<16;++r){int kv=kb+(r&3)+8*(r>>2); if(kv>qrel)p0[r]=NEG; if(kv+32>qrel)p1[r]=NEG;}
}

__device__ __forceinline__ void wmask(f32x16&p0,f32x16&p1,int k0,int qrel,int hi){
  const float NEG=-INFINITY; const int kb=k0+4*hi;
  #pragma unroll
  for(int r=0;r<16;++r){const int kv=kb+(r&3)+8*(r>>2); if((unsigned)(qrel-kv)>=128u)p0[r]=NEG; if((unsigned)(qrel-kv-32)>=128u)p1[r]=NEG;}
}
constexpr int NSLOT=3, SLOTB=8192;
constexpr int LDS_K=0, LDS_V=NSLOT*SLOTB, LDS_WS=2*NSLOT*SLOTB, LDS_OST=LDS_WS+NW*64*4, LDS_BYTES=LDS_OST+NW*4096;
constexpr float C2=0.125f*1.4426950408889634f;
__device__ __forceinline__ void glds16(const void*gsrc,unsigned lds_dst){unsigned keep;
  asm volatile("s_mov_b32 %0, m0\n\ts_mov_b32 m0, %2\n\ts_nop 0\n\tglobal_load_lds_dwordx4 %1, off\n\ts_mov_b32 m0, %0":"=&s"(keep):"v"(gsrc),"s"(lds_dst):"memory");}
__device__ __forceinline__ float max3f(float a,float b,float c){float r;asm("v_max3_f32 %0, %1, %2, %3":"=v"(r):"v"(a),"v"(b),"v"(c));return r;}
__device__ __forceinline__ float max2f(float a,float b){float r;asm("v_max_f32_e32 %0, %1, %2":"=v"(r):"v"(a),"v"(b));return r;}
__device__ __forceinline__ float fadd_s(float a,float b){float r;asm("v_add_f32_e32 %0, %1, %2":"=v"(r):"v"(a),"v"(b));return r;}
__device__ __forceinline__ float fsub_s(float a,float b){float r;asm("v_sub_f32_e32 %0, %1, %2":"=v"(r):"v"(a),"v"(b));return r;}
typedef float f32x2_t __attribute__((ext_vector_type(2))); typedef __bf16 bf16x2_t __attribute__((ext_vector_type(2)));
__device__ __forceinline__ unsigned cvtpk_s(float lo,float hi){f32x2_t v={lo,hi};bf16x2_t b=__builtin_convertvector(v,bf16x2_t);return __builtin_bit_cast(unsigned,b);}
#define WAIT_BAR(N) asm volatile("s_waitcnt vmcnt(" #N ") lgkmcnt(0)\n\ts_barrier":::"memory")

__device__ __forceinline__ void qkt(f32x16&p0,f32x16&p1,const char*Kslot,const bf16x8*qr,const f32x16&negm,int r32,int hi){
  const char*kb=Kslot+hi*1024+r32*16;
  #pragma unroll
  for(int d0=0;d0<4;++d0){
    const bf16x8 b0=*reinterpret_cast<const bf16x8*>(kb+d0*2048);
    const bf16x8 b1=*reinterpret_cast<const bf16x8*>(kb+d0*2048+512);
    if(d0==0){p0=__builtin_amdgcn_mfma_f32_32x32x16_bf16(b0,qr[0],negm,0,0,0);p1=__builtin_amdgcn_mfma_f32_32x32x16_bf16(b1,qr[0],negm,0,0,0);}
    else{p0=__builtin_amdgcn_mfma_f32_32x32x16_bf16(b0,qr[d0],p0,0,0,0);p1=__builtin_amdgcn_mfma_f32_32x32x16_bf16(b1,qr[d0],p1,0,0,0);}}
}
typedef __attribute__((address_space(3))) const char* lds_cptr;
typedef short v4i16_t __attribute__((ext_vector_type(4)));
__device__ __forceinline__ void kload8(bf16x8*kf,lds_cptr kp){
  kf[0]=*(const __attribute__((address_space(3))) bf16x8*)(kp);      kf[1]=*(const __attribute__((address_space(3))) bf16x8*)(kp+512);
  kf[2]=*(const __attribute__((address_space(3))) bf16x8*)(kp+2048); kf[3]=*(const __attribute__((address_space(3))) bf16x8*)(kp+2560);
  kf[4]=*(const __attribute__((address_space(3))) bf16x8*)(kp+4096); kf[5]=*(const __attribute__((address_space(3))) bf16x8*)(kp+4608);
  kf[6]=*(const __attribute__((address_space(3))) bf16x8*)(kp+6144); kf[7]=*(const __attribute__((address_space(3))) bf16x8*)(kp+6656);
}
__device__ __forceinline__ void kload2(bf16x8*kf,lds_cptr kp,int j){ kf[2*j]=*(const __attribute__((address_space(3))) bf16x8*)(kp+j*2048); kf[2*j+1]=*(const __attribute__((address_space(3))) bf16x8*)(kp+j*2048+512); }
__device__ __forceinline__ s16x4 vtr(lds_cptr p){ return __builtin_bit_cast(s16x4,__builtin_amdgcn_ds_read_tr16_b64_v4i16((__attribute__((address_space(3))) v4i16_t*)p)); }
__device__ __forceinline__ float rowmax(const f32x16&p0,const f32x16&p1){
  float a=max3f(p0[0],p0[1],p1[0]),b=max3f(p0[2],p0[3],p1[1]);a=max3f(a,p1[2],p1[3]);
  #pragma unroll
  for(int r=4;r<16;r+=4){a=max3f(a,p0[r],p0[r+1]);b=max3f(b,p0[r+2],p0[r+3]);a=max3f(a,p1[r],p1[r+1]);b=max3f(b,p1[r+2],p1[r+3]);}
  const float m=max2f(a,b);
  auto rr=__builtin_amdgcn_permlane32_swap(__float_as_uint(m),__float_as_uint(m),false,false);
  return max2f(__uint_as_float(rr[0]),__uint_as_float(rr[1]));
}
__device__ __forceinline__ void pv(f32x16*o,int vb,bf16x8 pa0,bf16x8 pa1,bf16x8 pa2,bf16x8 pa3){
  #pragma unroll
  for(int d0=0;d0<2;++d0){s16x4 lo[4],hi[4];
    #pragma unroll
    for(int ks=0;ks<4;++ks){
      asm volatile("ds_read_b64_tr_b16 %0,%1 offset:%c2":"=&v"(lo[ks]):"v"(vb),"i"(d0*4096+ks*1024):"memory");
      asm volatile("ds_read_b64_tr_b16 %0,%1 offset:%c2":"=&v"(hi[ks]):"v"(vb),"i"(d0*4096+ks*1024+512):"memory");}
    asm volatile("s_waitcnt lgkmcnt(0)":::"memory");SBAR();
    #define PK(k) (bf16x8){lo[k][0],lo[k][1],lo[k][2],lo[k][3],hi[k][0],hi[k][1],hi[k][2],hi[k][3]}
    o[d0]=__builtin_amdgcn_mfma_f32_32x32x16_bf16(pa0,PK(0),o[d0],0,0,0);
    o[d0]=__builtin_amdgcn_mfma_f32_32x32x16_bf16(pa1,PK(1),o[d0],0,0,0);
    o[d0]=__builtin_amdgcn_mfma_f32_32x32x16_bf16(pa2,PK(2),o[d0],0,0,0);
    o[d0]=__builtin_amdgcn_mfma_f32_32x32x16_bf16(pa3,PK(3),o[d0],0,0,0);
    #undef PK
  }
}

#ifndef ATTN_STORE16
#define ATTN_STORE16(p,v) (*(u32x4*)(p)=(v))
#endif
template<int THRL,int MODE,int QP,int KP> __device__ __forceinline__ void attn_unit(int b,int qb,int qcol,int kcol,const bf16*Q,const bf16*__restrict__ K,const bf16*__restrict__ V,bf16*O,const __attribute__((address_space(3))) float* kmean,float sink2,char*shm,int tid_in){
  int tid_l=tid_in; asm volatile("":"+v"(tid_l));
  const int tid=tid_l,lane=tid&63,r32=lane&31,hi=lane>>5; const int wid=__builtin_amdgcn_readfirstlane(tid>>6);
  const long rowbase=(long)b*SEQ; const int q0=qb*QB;
  const int T0=(MODE==1&&qb>0)?4*qb-2:0;
  const bf16*Qw=Q+(rowbase+q0+wid*QBLK)*QP+qcol;
  const bf16*Kh=K+(rowbase+T0*KVBLK)*KP+kcol,*Vh=V+(rowbase+T0*KVBLK)*KP+kcol;
  const unsigned lds0=(unsigned)(uintptr_t)shm;
  float*wsf=(float*)(shm+LDS_WS)+wid*64;
  const bf16*ksrc=Kh+(long)lane*KP+wid*8;
  const bf16*vsrc=Vh+(long)(16*(wid&3)+(lane>>2))*KP+(wid>>2)*32+(lane&3)*8;
  const unsigned kdst=lds0+LDS_K+wid*1024, vdst=lds0+LDS_V+wid*1024;
  #define DMA_K(t,slot) glds16(ksrc+(long)(t)*KVBLK*KP,(unsigned)__builtin_amdgcn_readfirstlane(kdst+(slot)))
  #define DMA_V(t,slot) glds16(vsrc+(long)(t)*KVBLK*KP,(unsigned)__builtin_amdgcn_readfirstlane(vdst+(slot)))
  const int vb0=(int)(lds0+LDS_V)+((lane>>4)&1)*32+(lane&3)*8+(4*hi+((lane&15)>>2))*64;
  const char*Kbase=shm+LDS_K; bf16x8 kf[8];
  const lds_cptr shm3=(lds_cptr)shm; const lds_cptr kp0=shm3+LDS_K+hi*1024+r32*16; const lds_cptr vp0=shm3+LDS_V+((lane>>4)&1)*32+(lane&3)*8+(4*hi+((lane&15)>>2))*64;
  const int NT=(MODE==1)?((qb>0)?6:4):(q0+QB)/KVBLK;
  DMA_K(0,0);DMA_V(0,0);DMA_K(1,SLOTB);
  bf16x8 qr[4];
  #pragma unroll
  for(int d0=0;d0<4;++d0)qr[d0]=*reinterpret_cast<const bf16x8*>(&Qw[(long)r32*QP+d0*16+hi*8]);
  float zl_=0.f; asm volatile("":"+v"(zl_));
  float mhat=0.f,l_reg=0.f;f32x16 o[2],negm;
  #pragma unroll
  for(int r_=0;r_<16;++r_){o[0][r_]=zl_;o[1][r_]=zl_;negm[r_]=zl_;}
  asm volatile("":"+v"(negm));
  const int qrel=wid*QBLK+r32;
  unsigned selmask=0u;
  if(MODE==0){ float v1=-INFINITY,v2=-INFINITY,v3=-INFINITY; int i1=-1,i2=-1,i3=-1;
    for(int j=0;j<qb;++j){ const __attribute__((address_space(3))) float*km=kmean+j*64+hi*8; float g=0.f;
      #pragma unroll
      for(int d0=0;d0<4;++d0){ const f32x4 ka=*(const __attribute__((address_space(3))) f32x4*)(km+d0*16), kb=*(const __attribute__((address_space(3))) f32x4*)(km+d0*16+4);
        #pragma unroll
        for(int e=0;e<4;++e){ g=__builtin_fmaf(__uint_as_float(((unsigned)(unsigned short)qr[d0][e])<<16),ka[e],g); g=__builtin_fmaf(__uint_as_float(((unsigned)(unsigned short)qr[d0][4+e])<<16),kb[e],g);} }
      { auto rr_=__builtin_amdgcn_permlane32_swap(__float_as_uint(g),__float_as_uint(g),false,false); g=__uint_as_float(rr_[0])+__uint_as_float(rr_[1]); }
      if(g>v1){v3=v2;i3=i2;v2=v1;i2=i1;v1=g;i1=j;} else if(g>v2){v3=v2;i3=i2;v2=g;i2=j;} else if(g>v3){v3=g;i3=j;} }
    if(i1>=0)selmask|=1u<<i1; if(i2>=0)selmask|=1u<<i2; if(i3>=0)selmask|=1u<<i3; }
  const int wk0=(T0-4*qb)*KVBLK;
  #define BMASK(P0,P1,t) do{ if(!((selmask>>((t)>>2))&1u)){ _Pragma("unroll") for(int r_=0;r_<16;++r_){P0[r_]=-INFINITY;P1[r_]=-INFINITY;} } }while(0)
  #define CMASK(P0,P1,t) do{ if(MODE==1){ wmask(P0,P1,wk0+64*(t),qrel,hi); } else { int jb_=(t)-(NT-4); if(jb_>=0)cmask(P0,P1,jb_,qrel,hi); else BMASK(P0,P1,t); } }while(0)
  bool resc=false;
  #define START(P0,P1) do{ const float rm=rowmax(P0,P1); resc=false; \
    { const float dl=__builtin_fmaxf(rm,-100.f); mhat=fadd_s(mhat,dl); \
      _Pragma("unroll") for(int r=0;r<16;++r){P0[r]=fsub_s(P0[r],dl);P1[r]=fsub_s(P1[r],dl);} \
      _Pragma("unroll") for(int r=0;r<16;++r)negm[r]=-mhat; asm volatile("":"+v"(negm)); } \
    _Pragma("unroll") for(int r=0;r<16;++r)P0[r]=__builtin_amdgcn_exp2f(P0[r]); }while(0)
  #define RESC() do{ if(resc){ asm volatile("s_waitcnt lgkmcnt(0)":::"memory"); \
      _Pragma("unroll") for(int d_=0;d_<2;++d_) _Pragma("unroll") for(int r=0;r<16;++r)o[d_][r]*=wsf[crow(r,hi)]; } }while(0)
  f32x16 pA0,pA1,pB0,pB1;
  int sl_prev=0,sl_cur=0,sl_next=SLOTB;
  #define ROT() do{sl_prev=sl_cur;sl_cur=sl_next;sl_next=(sl_next==(NSLOT-1)*SLOTB)?0:sl_next+SLOTB;}while(0)
  DMA_K(2,2*SLOTB);
  WAIT_BAR(3);
  qkt(pA0,pA1,Kbase,qr,negm,r32,hi);asm volatile("s_nop 15\n\ts_nop 7":"+v"(pA0),"+v"(pA1));CMASK(pA0,pA1,0);
  START(pA0,pA1);
  _Pragma("unroll") for(int r=0;r<16;++r)pA1[r]=__builtin_amdgcn_exp2f(pA1[r]);
  WAIT_BAR(0);
  DMA_K(3,0);DMA_V(1,SLOTB);
  ROT();
  kload8(kf,kp0+sl_cur);
  WAIT_BAR(2);
  s16x4 vlo[8],vhi[8]; u32x4 pw0,pw1,pw2,pw3;
  #define PKW(P,B) cvtpk_s(P[B],P[B+1])
  #define PAF(k) __builtin_bit_cast(bf16x8,pw##k)
  #define VFR(i) (bf16x8){vlo[i][0],vlo[i][1],vlo[i][2],vlo[i][3],vhi[i][0],vhi[i][1],vhi[i][2],vhi[i][3]}
  #define PIN(x) asm volatile("":"+v"(x))
  #define MX3(a,b,c) __builtin_fmaxf(__builtin_fmaxf((a),(b)),(c))
  #define GAPA(MF,A0,A1,A2,A3,W0,W1,PW) do{ MF; sacc+=A0; sacc+=A1; sacc+=A2; sacc+=A3; PIN(sacc); W0; W1; PIN(PW); SBAR(); }while(0)
  #define EX(v) __builtin_amdgcn_exp2f(v)
  #define GAPB(MF,X,B) do{ MF; X[B]=EX(X[B]); X[B+1]=EX(X[B+1]); X[B+2]=EX(X[B+2]); X[B+3]=EX(X[B+3]); PIN(X); SBAR(); }while(0)
  #define VRD(i) do{ vlo[i]=vtr(vp_+(((i)>>2)*4096+((i)&3)*1024)); vhi[i]=vtr(vp_+(((i)>>2)*4096+((i)&3)*1024+512)); }while(0)
  #define KRD(G,j) do{ if(G){ kload2(kf,kp0+sl_next,j); SBAR(); } }while(0)
  #define STEP(C0,C1,P0,P1,t,GK,GV,GL) do{ SBAR(); \
    const lds_cptr vp_=vp0+sl_prev; \
    VRD(0); SBAR(); float sacc=(P0[0]+P0[1]); \
    GAPA(C0=__builtin_amdgcn_mfma_f32_32x32x16_bf16(kf[0],qr[0],negm,0,0,0), P0[2],P0[3],P0[4],P0[5],     pw0[0]=PKW(P0,0), pw0[1]=PKW(P0,2), pw0); \
    VRD(4); SBAR(); GAPA(C1=__builtin_amdgcn_mfma_f32_32x32x16_bf16(kf[1],qr[0],negm,0,0,0), P0[6],P0[7],P0[8],P0[9],     pw0[2]=PKW(P0,4), pw0[3]=PKW(P0,6), pw0); \
    VRD(1); SBAR(); GAPA(C0=__builtin_amdgcn_mfma_f32_32x32x16_bf16(kf[2],qr[1],C0,0,0,0),   P0[10],P0[11],P0[12],P0[13], pw1[0]=PKW(P0,8), pw1[1]=PKW(P0,10), pw1); \
    VRD(5); SBAR(); GAPA(C1=__builtin_amdgcn_mfma_f32_32x32x16_bf16(kf[3],qr[1],C1,0,0,0),   P0[14],P0[15],P1[0],P1[1],   pw1[2]=PKW(P0,12),pw1[3]=PKW(P0,14), pw1); \
    VRD(2); SBAR(); GAPA(C0=__builtin_amdgcn_mfma_f32_32x32x16_bf16(kf[4],qr[2],C0,0,0,0),   P1[2],P1[3],P1[4],P1[5],     pw2[0]=PKW(P1,0), pw2[1]=PKW(P1,2), pw2); \
    VRD(6); SBAR(); GAPA(C1=__builtin_amdgcn_mfma_f32_32x32x16_bf16(kf[5],qr[2],C1,0,0,0),   P1[6],P1[7],P1[8],P1[9],     pw2[2]=PKW(P1,4), pw2[3]=PKW(P1,6), pw2); \
    VRD(3); SBAR(); GAPA(C0=__builtin_amdgcn_mfma_f32_32x32x16_bf16(kf[6],qr[3],C0,0,0,0),   P1[10],P1[11],P1[12],P1[13], pw3[0]=PKW(P1,8), pw3[1]=PKW(P1,10), pw3); \
    VRD(7); SBAR(); GAPA(C1=__builtin_amdgcn_mfma_f32_32x32x16_bf16(kf[7],qr[3],C1,0,0,0),   P1[14],P1[15],0.f,0.f,       pw3[2]=PKW(P1,12),pw3[3]=PKW(P1,14), pw3); \
    l_reg+=sacc; \
    if(GK){DMA_K((t)+3,sl_cur);} if(GV){DMA_V((t)+1,sl_next);} \
    CMASK(C0,C1,t); \
    { float a=MX3(C0[0],C0[1],C1[0]),b=MX3(C0[2],C0[3],C1[1]); a=MX3(a,C1[2],C1[3]); \
      _Pragma("unroll") for(int r=4;r<16;r+=4){a=MX3(a,C0[r],C0[r+1]);b=MX3(b,C0[r+2],C0[r+3]);a=MX3(a,C1[r],C1[r+1]);b=MX3(b,C1[r+2],C1[r+3]);} \
      float rm=__builtin_fmaxf(a,b); { auto rr=__builtin_amdgcn_permlane32_swap(__float_as_uint(rm),__float_as_uint(rm),false,false); rm=__builtin_fmaxf(__uint_as_float(rr[0]),__uint_as_float(rr[1])); } \
      resc=false; \
      if(__builtin_expect(__any(rm>(float)THRL),0)){ const float dl=__builtin_fmaxf(rm,0.f); mhat+=dl; \
        _Pragma("unroll") for(int r=0;r<16;++r){C0[r]-=dl;C1[r]-=dl;} \
        _Pragma("unroll") for(int r=0;r<16;++r)negm[r]=-mhat; asm volatile("":"+v"(negm)); \
        const float f=__builtin_amdgcn_exp2f(-dl); l_reg*=f; if(hi==0)wsf[r32]=f; resc=true; } } \
    SBAR(); \
    GAPB(o[0]=__builtin_amdgcn_mfma_f32_32x32x16_bf16(PAF(0),VFR(0),o[0],0,0,0), C0,0); \
    GAPB(o[1]=__builtin_amdgcn_mfma_f32_32x32x16_bf16(PAF(0),VFR(4),o[1],0,0,0), C0,4); \
    KRD(GL,0); GAPB(o[0]=__builtin_amdgcn_mfma_f32_32x32x16_bf16(PAF(1),VFR(1),o[0],0,0,0), C0,8); \
    KRD(GL,1); GAPB(o[1]=__builtin_amdgcn_mfma_f32_32x32x16_bf16(PAF(1),VFR(5),o[1],0,0,0), C0,12); \
    KRD(GL,2); GAPB(o[0]=__builtin_amdgcn_mfma_f32_32x32x16_bf16(PAF(2),VFR(2),o[0],0,0,0), C1,0); \
    KRD(GL,3); GAPB(o[1]=__builtin_amdgcn_mfma_f32_32x32x16_bf16(PAF(2),VFR(6),o[1],0,0,0), C1,4); \
    GAPB(o[0]=__builtin_amdgcn_mfma_f32_32x32x16_bf16(PAF(3),VFR(3),o[0],0,0,0), C1,8); \
    GAPB(o[1]=__builtin_amdgcn_mfma_f32_32x32x16_bf16(PAF(3),VFR(7),o[1],0,0,0), C1,12); \
    }while(0)
  int t=1;
  #undef CMASK
  #define CMASK(P0,P1,t) do{ if(MODE==0)BMASK(P0,P1,t); }while(0)
  for(;t+5<NT;t+=2){
    STEP(pB0,pB1,pA0,pA1,t,true,true,true);     WAIT_BAR(2); RESC(); ROT();
    STEP(pA0,pA1,pB0,pB1,t+1,true,true,true);   WAIT_BAR(2); RESC(); ROT();
  }
  #undef CMASK
  #define CMASK(P0,P1,t) do{ if(MODE==1){ wmask(P0,P1,wk0+64*(t),qrel,hi); } else { int jb_=(t)-(NT-4); if(jb_>=0)cmask(P0,P1,jb_,qrel,hi); else BMASK(P0,P1,t); } }while(0)
  #define ENDW(tt) do{ if((tt)+3<NT){WAIT_BAR(2);} else if((tt)+2<NT){WAIT_BAR(1);} else {WAIT_BAR(0);} }while(0)
  for(;t+1<NT;t+=2){
    STEP(pB0,pB1,pA0,pA1,t,(t+3<NT),(t+1<NT),(t+1<NT));       ENDW(t);   RESC(); ROT();
    STEP(pA0,pA1,pB0,pB1,t+1,(t+4<NT),(t+2<NT),(t+2<NT));     ENDW(t+1); RESC(); ROT();
  }
  STEP(pB0,pB1,pA0,pA1,NT-1,false,false,false); RESC();
  { float sacc=pB0[0]+pB0[1]; _Pragma("unroll") for(int r=2;r<16;++r)sacc+=pB0[r]; _Pragma("unroll") for(int r=0;r<16;++r)sacc+=pB1[r]; l_reg+=sacc;
    pw0=(u32x4){PKW(pB0,0),PKW(pB0,2),PKW(pB0,4),PKW(pB0,6)};pw1=(u32x4){PKW(pB0,8),PKW(pB0,10),PKW(pB0,12),PKW(pB0,14)};pw2=(u32x4){PKW(pB1,0),PKW(pB1,2),PKW(pB1,4),PKW(pB1,6)};pw3=(u32x4){PKW(pB1,8),PKW(pB1,10),PKW(pB1,12),PKW(pB1,14)};
    SBAR(); pv(o,vb0+sl_cur,PAF(0),PAF(1),PAF(2),PAF(3)); }
  #undef PKW
  #undef PAF
  #undef VFR
  #undef PIN
  #undef MX3
  #undef GAPA
  #undef GAPB
  #undef EX
  #undef VRD
  #undef KRD
  #undef STEP
  #undef ENDW
  {auto rr=__builtin_amdgcn_permlane32_swap(__float_as_uint(l_reg),__float_as_uint(l_reg),false,false);l_reg=__uint_as_float(rr[0])+__uint_as_float(rr[1]);}
  if(MODE==1)l_reg+=__builtin_amdgcn_exp2f(sink2-mhat);
  if(hi==0)wsf[32+r32]=l_reg;asm volatile("s_waitcnt lgkmcnt(0)":::"memory");
  float rli[16];
  #pragma unroll
  for(int r=0;r<16;++r)rli[r]=__builtin_amdgcn_rcpf(wsf[32+crow(r,hi)]);
  bf16*Ow=O+(rowbase+q0+wid*QBLK)*QP+qcol;
  { bf16*stg=(bf16*)(shm+LDS_OST)+wid*2048;
    #pragma unroll
    for(int r=0;r<16;++r){const int orow=crow(r,hi);
      #pragma unroll
      for(int d0=0;d0<2;++d0)stg[orow*64+d0*32+r32]=__float2bfloat16(o[d0][r]*rli[r]);}
    asm volatile("s_waitcnt lgkmcnt(0)":::"memory");
    #pragma unroll
    for(int i=0;i<4;++i){const int row=i*8+(lane>>3),ch=lane&7; const u32x4 v=*(const u32x4*)(stg+row*64+ch*8); ATTN_STORE16(Ow+(long)row*QP+ch*8,v);} }
  asm volatile("s_waitcnt lgkmcnt(0)\n\ts_barrier":::"memory");
  #undef DMA_K
  #undef DMA_V
  #undef CMASK
  #undef BMASK
  #undef START
  #undef RESC
  #undef ROT
}
constexpr int ATTN_LDS_BYTES=LDS_BYTES;
#undef SBAR
#undef WAIT_BAR
}

#include <hip/hip_cooperative_groups.h>
namespace cg = cooperative_groups;
#define LAS __attribute__((address_space(3)))
typedef pg8::f32x4 f32x4;
typedef unsigned u32x4 __attribute__((ext_vector_type(4)));
typedef unsigned u32x2 __attribute__((ext_vector_type(2)));
typedef float f32x2_t __attribute__((ext_vector_type(2))); typedef __bf16 bf16x2_t __attribute__((ext_vector_type(2)));
DEVI unsigned pk2(float lo, float hi) { f32x2_t v = {lo, hi}; bf16x2_t b = __builtin_convertvector(v, bf16x2_t); return __builtin_bit_cast(unsigned, b); }
DEVI float bflo(unsigned u) { return __uint_as_float(u << 16); }
DEVI float bfhi(unsigned u) { return __uint_as_float(u & 0xffff0000u); }

DEVI int mk_lane_id() { int l; asm volatile("v_mbcnt_lo_u32_b32 %0, -1, 0\n\tv_mbcnt_hi_u32_b32 %0, -1, %0" : "=v"(l)); return l; }
DEVI float bperm_xor(float v, int lane, int mask) { return __int_as_float(__builtin_amdgcn_ds_bpermute((lane ^ mask) << 2, __float_as_int(v))); }
DEVI float wave_sum_l(float v, int lane) {
#pragma unroll
    for (int o = 1; o < 64; o <<= 1) v += bperm_xor(v, lane, o);
    return v;
}
constexpr size_t WO_IN = 0, WO_GATE = 6815744, WO_BR = WO_GATE + 6 * MiB, WO_OUT = WO_BR + 3 * MiB, WO_FF1 = WO_OUT + 2 * MiB, WO_FF2 = WO_FF1 + 8 * MiB;
static_assert(WO_FF2 + 8 * MiB <= 34 * MiB, "W region");
constexpr int NPERM = 3328;

DEVI int win_src_col(int np) {
    int s0, nat, rope;
    if (np < 512) { s0 = 0; nat = 0; rope = 1; }
    else if (np < 576) { s0 = 512; nat = 512; rope = 1; }
    else if (np < 640) { s0 = 576; nat = 576; rope = 0; }
    else if (np < 896) { s0 = 640; nat = 640; rope = 1; }
    else if (np < 960) { s0 = 896; nat = 896; rope = 1; }
    else if (np < 1472) { s0 = 960; nat = 964; rope = 1; }
    else if (np < 1600) { s0 = 1472; nat = 1476; rope = 1; }
    else if (np < 1728) { s0 = 1600; nat = 1604; rope = 0; }
    else if (np < 2240) { s0 = 1728; nat = 1732; rope = 1; }
    else if (np < 2752) { s0 = 2240; nat = 2244; rope = 1; }
    else if (np < 3264) { s0 = 2752; nat = 2756; rope = 0; }
    else { const int r = np - 3264; return (r < 4) ? 960 + r : -1; }
    const int r = np - s0;
    if (!rope) return nat + r;
    const int hb = r >> 6, w = r & 63;
    return nat + 64 * hb + (w >> 1) + 32 * (w & 1);
}
struct MapWin { DEVI int operator()(int n) const { return win_src_col(n); } };
struct MapOff { int off; DEVI int operator()(int n) const { return off + n; } };

struct TrItem { const float* W; bf16_t* WT; int ldw, K, k0, n0, sc; };
DEVI void tr_load(const TrItem& t, float (&v)[32], int lane) {
    const float* p = t.W + (size_t)(t.k0 + (lane >> 5)) * t.ldw + (t.sc >= 0 ? t.sc : 0);
    const unsigned msk = (t.sc >= 0) ? 0xffffffffu : 0u;
#pragma unroll
    for (int i = 0; i < 32; ++i) v[i] = __uint_as_float(__float_as_uint(p[(size_t)(2 * i) * t.ldw]) & msk);
}
DEVI void tr_store(const TrItem& t, const float (&v)[32], LAS float* scr, int lane) {
#pragma unroll
    for (int i = 0; i < 32; ++i) scr[(2 * i + (lane >> 5)) * 33 + (lane & 31)] = v[i];
    asm volatile("s_waitcnt lgkmcnt(0)" ::: "memory");
    const int c = lane & 7;
#pragma unroll
    for (int j = 0; j < 4; ++j) {
        const int n = (lane >> 3) + 8 * j; const LAS float* s = scr + (8 * c) * 33 + n;
        u32x4 o; o.x = pk2(s[0 * 33], s[1 * 33]); o.y = pk2(s[2 * 33], s[3 * 33]); o.z = pk2(s[4 * 33], s[5 * 33]); o.w = pk2(s[6 * 33], s[7 * 33]);
        *(u32x4*)(t.WT + (size_t)(t.n0 + n) * t.K + t.k0 + 8 * c) = o;
    }
    asm volatile("s_waitcnt lgkmcnt(0)" ::: "memory");
}

constexpr int RSTD_TAB_OFF = 131072;
template <class Sched>
DEVI void fill_rstd_table(const Sched& S, const float* SSQ, LAS unsigned char* lds, int tid) {
    LAS float* tab = (LAS float*)(lds + RSTD_TAB_OFF);
#pragma unroll
    for (int k = 0; k < 2; ++k) {
        const int i = (tid >> 8) + 2 * k; pg8::Unit u;
        if (S.next(i, u)) tab[i * 256 + (tid & 255)] = rstd_of(SSQ, u.pm * 256 + (tid & 255));
    }
    asm volatile("s_waitcnt lgkmcnt(0)" ::: "memory"); __builtin_amdgcn_s_barrier();
}
struct EpiProjMK {
    static constexpr bool PERM = true, AFTER_DRAIN = false, PROBE_DBL = false;
    const LAS float* tab; unsigned char* ws; const float* COS; const float* SIN;
    DEVI void operator()(const f32x4 (&acc)[2][2][4][2], const pg8::Unit& u, int wr, int wc, int fr, int fq) const {
        const int row0 = u.pm * 256 + wr * 64 + fr;
        const int j = 4 * (wc & 1) + fq;
        f32x4 ks1[2], ks2[2];
#pragma unroll
        for (int bj = 0; bj < 2; ++bj) { ks1[bj] = (f32x4){0.f, 0.f, 0.f, 0.f}; ks2[bj] = ks1[bj]; }
#pragma unroll
        for (int ai = 0; ai < 2; ++ai) {
            f32x4 c4[4], s4[4]; float rs[4];
#pragma unroll
            for (int m = 0; m < 4; ++m) {
                const int row = row0 + ai * 128 + m * 16, pos = row & (SEQ - 1);
                c4[m] = *(const f32x4*)(COS + pos * 32 + 4 * j); s4[m] = *(const f32x4*)(SIN + pos * 32 + 4 * j);
                rs[m] = tab[u.ord * 256 + wr * 64 + fr + ai * 128 + m * 16];
            }
#pragma unroll
            for (int bj = 0; bj < 2; ++bj) {
                const int np0 = (4 * u.pn + 2 * bj + (wc >> 1)) * 64;
                size_t off; int pitch, dcol, mode;
                if (np0 < 512) { off = WS_AQ; pitch = 512; dcol = np0; mode = 2; }
                else if (np0 < 576) { off = WS_AK; pitch = 64; dcol = 0; mode = 1; }
                else if (np0 < 640) { off = WS_AV; pitch = 64; dcol = 0; mode = 0; }
                else if (np0 < 896) { off = WS_IQ; pitch = 256; dcol = np0 - 640; mode = 1; }
                else if (np0 < 960) { off = WS_IK; pitch = 64; dcol = 0; mode = 1; }
                else if (np0 < 1472) { off = WS_BQ; pitch = 512; dcol = np0 - 960; mode = 2; }
                else if (np0 < 1600) { off = WS_BK; pitch = 128; dcol = np0 - 1472; mode = 1; }
                else if (np0 < 1728) { off = WS_BV; pitch = 128; dcol = np0 - 1600; mode = 0; }
                else if (np0 < 2240) { off = WS_CQ; pitch = 512; dcol = np0 - 1728; mode = 2; }
                else if (np0 < 2752) { off = WS_CK; pitch = 512; dcol = np0 - 2240; mode = 1; }
                else if (np0 < 3264) { off = WS_CV; pitch = 512; dcol = np0 - 2752; mode = 0; }
                else { off = WS_IW; pitch = 4; dcol = 0; mode = 3; }
                bf16_t* dst = (bf16_t*)(ws + off);
                const float sc = (mode == 2) ? C2 : 1.0f;
#pragma unroll
                for (int m = 0; m < 4; ++m) {
                    const int row = row0 + ai * 128 + m * 16;
                    const f32x4 v0 = acc[ai][bj][m][0] * rs[m], v1 = acc[ai][bj][m][1] * rs[m];
                    if (mode == 0) {
                        u32x4 w; w.x = pk2(v0[0], v0[1]); w.y = pk2(v0[2], v0[3]); w.z = pk2(v1[0], v1[1]); w.w = pk2(v1[2], v1[3]);
                        *(u32x4*)(dst + (size_t)row * pitch + dcol + 8 * j) = w;
                    } else if (mode == 3) {
                        if (j == 0) *(f32x4*)((float*)(ws + off) + (size_t)row * 4) = v0;
                    } else {
                        const f32x4 x1 = {v0[0], v0[2], v1[0], v1[2]}, x2 = {v0[1], v0[3], v1[1], v1[3]};
                        const f32x4 o1 = (x1 * c4[m] - x2 * s4[m]) * sc, o2 = (x1 * s4[m] + x2 * c4[m]) * sc;
                        u32x2 a, b; a.x = pk2(o1[0], o1[1]); a.y = pk2(o1[2], o1[3]); b.x = pk2(o2[0], o2[1]); b.y = pk2(o2[2], o2[3]);
                        bf16_t* p = dst + (size_t)row * pitch + dcol + 4 * j;
                        *(u32x2*)p = a; *(u32x2*)(p + 32) = b;
                        if (off == WS_CK) { ks1[bj] += o1; ks2[bj] += o2; }
                    }
                }
            }
            asm volatile("" ::: "memory");
        }
#pragma unroll
        for (int bj = 0; bj < 2; ++bj) {
            const int np0 = (4 * u.pn + 2 * bj + (wc >> 1)) * 64;
            if (np0 >= 2240 && np0 < 2752) {
                const int ln = fq * 16 + fr;
#pragma unroll
                for (int e = 0; e < 4; ++e) {
                    float a = ks1[bj][e], b = ks2[bj][e];
#pragma unroll
                    for (int o = 1; o < 16; o <<= 1) { a += bperm_xor(a, ln, o); b += bperm_xor(b, ln, o); }
                    ks1[bj][e] = a; ks2[bj][e] = b;
                }
                if (fr == 0) {
                    float* km = (float*)(ws + WS_KMEAN) + ((size_t)((u.pm >> 5) * 8 + ((np0 - 2240) >> 6)) * 32 + (u.pm & 31)) * 64 + 4 * j;
#pragma unroll
                    for (int e = 0; e < 4; ++e) { atomicAdd(km + e, ks1[bj][e] * (1.0f / 256.0f)); atomicAdd(km + 32 + e, ks2[bj][e] * (1.0f / 256.0f)); }
                }
            }
        }
    }
};
template <int ACT> struct EpiActMK {
    static constexpr bool PERM = true, AFTER_DRAIN = false, PROBE_DBL = (ACT == 1);
    const LAS float* tab; void* Ov; int ldc;
    DEVI void operator()(const f32x4 (&acc)[2][2][4][2], const pg8::Unit& u, int wr, int wc, int fr, int fq) const {
        const int row0 = u.pm * 256 + wr * 64 + fr, col0 = u.pn * 256 + wc * 32 + 8 * fq;
#pragma unroll
        for (int ai = 0; ai < 2; ++ai)
#pragma unroll
            for (int m = 0; m < 4; ++m) {
                const int row = row0 + ai * 128 + m * 16; float rs = tab[u.ord * 256 + wr * 64 + fr + ai * 128 + m * 16];
                if (ACT == 0) rs *= -LOG2E;
#pragma unroll
                for (int bj = 0; bj < 2; ++bj) {
                    float v[8];
#pragma unroll
                    for (int e = 0; e < 4; ++e) { v[e] = acc[ai][bj][m][0][e] * rs; v[4 + e] = acc[ai][bj][m][1][e] * rs; }
                    if constexpr (ACT == 0) {
#pragma unroll
                        for (int e = 0; e < 8; ++e) v[e] = __builtin_amdgcn_rcpf(__builtin_fmaf(__builtin_amdgcn_exp2f(v[e]), 1.0f / 255.0f, 1.0f / 255.0f));
                        unsigned lo = 0u, hi = 0u;
                        lo = __builtin_amdgcn_cvt_pk_u8_f32(v[0], 0, lo); lo = __builtin_amdgcn_cvt_pk_u8_f32(v[1], 1, lo); lo = __builtin_amdgcn_cvt_pk_u8_f32(v[2], 2, lo); lo = __builtin_amdgcn_cvt_pk_u8_f32(v[3], 3, lo);
                        hi = __builtin_amdgcn_cvt_pk_u8_f32(v[4], 0, hi); hi = __builtin_amdgcn_cvt_pk_u8_f32(v[5], 1, hi); hi = __builtin_amdgcn_cvt_pk_u8_f32(v[6], 2, hi); hi = __builtin_amdgcn_cvt_pk_u8_f32(v[7], 3, hi);
                        u32x2 w; w.x = lo; w.y = hi;
                        *(u32x2*)((unsigned char*)Ov + (size_t)row * ldc + col0 + bj * 128) = w;
                    } else {
#pragma unroll
                        for (int e = 0; e < 8; ++e) { const float t = fmaxf(v[e], 0.f); v[e] = t * t; }
                        u32x4 w; w.x = pk2(v[0], v[1]); w.y = pk2(v[2], v[3]); w.z = pk2(v[4], v[5]); w.w = pk2(v[6], v[7]);
                        *(u32x4*)((bf16_t*)Ov + (size_t)row * ldc + col0 + bj * 128) = w;
                    }
                }
            }
    }
};
struct BranchOrder {
    pg8::StaticOrder S; int gm, gpm, gj;
    __device__ bool next(int i, pg8::Unit& u) const { pg8::Unit t; const int ti = i / 3, br = i - 3 * ti;
        if (gm) { if (ti != 0) return false; t.pm = gpm; t.pn = gj; } else if (!S.next(ti, t)) return false;
        u.pm = 64 * br + t.pm; u.pn = 4 * br + t.pn; u.ord = br; return true; }
    DEVI void a_ready(const pg8::Unit&) const {}
    DEVI void done(const pg8::Unit&) const {}
};
struct EpiBranchMK {
    static constexpr bool PERM = true, AFTER_DRAIN = false, PROBE_DBL = false;
    const unsigned char* GS; bf16_t* MG;
    DEVI void operator()(const f32x4 (&acc)[2][2][4][2], const pg8::Unit& u, int wr, int wc, int fr, int fq) const {
        const int br = u.ord;
        const int row0 = (u.pm - 64 * br) * 256 + wr * 64 + fr, col0 = (u.pn - 4 * br) * 256 + wc * 32 + 8 * fq;
#pragma unroll
        for (int ai = 0; ai < 2; ++ai) {
            u32x2 gg[4][2]; u32x4 oo[4][2];
#pragma unroll
            for (int m = 0; m < 4; ++m)
#pragma unroll
                for (int bj = 0; bj < 2; ++bj) {
                    const int row = row0 + ai * 128 + m * 16, col = col0 + bj * 128;
                    gg[m][bj] = *(const u32x2*)(GS + (size_t)row * 3072 + br * 1024 + col);
                    oo[m][bj] = (br > 0) ? *(const u32x4*)(MG + (size_t)row * 1024 + col) : (u32x4){0u, 0u, 0u, 0u};
                }
#pragma unroll
            for (int m = 0; m < 4; ++m)
#pragma unroll
                for (int bj = 0; bj < 2; ++bj) {
                    const int row = row0 + ai * 128 + m * 16, col = col0 + bj * 128;
                    const u32x2 g = gg[m][bj]; const u32x4 o = oo[m][bj];
                    const float k = 1.0f / 255.0f;
                    float v[8];
                    v[0] = (float)(g.x & 0xffu) * k * acc[ai][bj][m][0][0]; v[1] = (float)((g.x >> 8) & 0xffu) * k * acc[ai][bj][m][0][1];
                    v[2] = (float)((g.x >> 16) & 0xffu) * k * acc[ai][bj][m][0][2]; v[3] = (float)(g.x >> 24) * k * acc[ai][bj][m][0][3];
                    v[4] = (float)(g.y & 0xffu) * k * acc[ai][bj][m][1][0]; v[5] = (float)((g.y >> 8) & 0xffu) * k * acc[ai][bj][m][1][1];
                    v[6] = (float)((g.y >> 16) & 0xffu) * k * acc[ai][bj][m][1][2]; v[7] = (float)(g.y >> 24) * k * acc[ai][bj][m][1][3];
                    if (br > 0) { v[0] += bflo(o.x); v[1] += bfhi(o.x); v[2] += bflo(o.y); v[3] += bfhi(o.y); v[4] += bflo(o.z); v[5] += bfhi(o.z); v[6] += bflo(o.w); v[7] += bfhi(o.w); }
                    u32x4 w; w.x = pk2(v[0], v[1]); w.y = pk2(v[2], v[3]); w.z = pk2(v[4], v[5]); w.w = pk2(v[6], v[7]);
                    *(u32x4*)(MG + (size_t)row * 1024 + col) = w;
                }
            asm volatile("" ::: "memory");
        }
    }
};
struct EpiResMK {
    static constexpr bool PERM = true, AFTER_DRAIN = false, PROBE_DBL = false;
    const float* xin; float* out; const float* g; bf16_t* XG; float* SSQ;
    DEVI void operator()(const f32x4 (&acc)[2][2][4][2], const pg8::Unit& u, int wr, int wc, int fr, int fq) const {
        const int row0 = u.pm * 256 + wr * 64 + fr, col0 = u.pn * 256 + wc * 32 + 8 * fq;
        f32x4 gv[2][2];
#pragma unroll
        for (int bj = 0; bj < 2; ++bj) { if (g) { gv[bj][0] = *(const f32x4*)(g + col0 + bj * 128); gv[bj][1] = *(const f32x4*)(g + col0 + bj * 128 + 4); } else { gv[bj][0] = (f32x4){1.f, 1.f, 1.f, 1.f}; gv[bj][1] = gv[bj][0]; } }
#pragma unroll
        for (int ai = 0; ai < 2; ++ai)
#pragma unroll
        for (int mh = 0; mh < 2; ++mh) {
            f32x4 xr[2][2][2];
#pragma unroll
            for (int mm = 0; mm < 2; ++mm)
#pragma unroll
                for (int bj = 0; bj < 2; ++bj) { const size_t o = (size_t)(row0 + ai * 128 + (2 * mh + mm) * 16) * 1024 + col0 + bj * 128; xr[mm][bj][0] = *(const f32x4*)(xin + o); xr[mm][bj][1] = *(const f32x4*)(xin + o + 4); }
#pragma unroll
            for (int mm = 0; mm < 2; ++mm) {
                const int m = 2 * mh + mm;
                const int row = row0 + ai * 128 + m * 16;
                float s = 0.f;
#pragma unroll
                for (int bj = 0; bj < 2; ++bj) {
                    const size_t o = (size_t)row * 1024 + col0 + bj * 128;
                    const f32x4 y0 = xr[mm][bj][0] + acc[ai][bj][m][0], y1 = xr[mm][bj][1] + acc[ai][bj][m][1];
                    *(f32x4*)(out + o) = y0; *(f32x4*)(out + o + 4) = y1;
                    s += (y0[0] * y0[0] + y0[1] * y0[1]) + (y0[2] * y0[2] + y0[3] * y0[3]) + (y1[0] * y1[0] + y1[1] * y1[1]) + (y1[2] * y1[2] + y1[3] * y1[3]);
                    if (g) {
                        const f32x4 z0 = y0 * gv[bj][0], z1 = y1 * gv[bj][1];
                        u32x4 w; w.x = pk2(z0[0], z0[1]); w.y = pk2(z0[2], z0[3]); w.z = pk2(z1[0], z1[1]); w.w = pk2(z1[2], z1[3]);
                        *(u32x4*)(XG + o) = w;
                    }
                }
                { const int ln = fq * 16 + fr; s += bperm_xor(s, ln, 16); s += bperm_xor(s, ln, 32); }
                if (fq == 0) SSQ[(size_t)row * 16 + u.pn * 4 + wc] = s;
            }
            asm volatile("" ::: "memory");
        }
    }
};


#define XB_TMO      128
#define XB_XCNT(j)  (256  + 64 * (j))
#define XB_XSUB(j)  (1280 + 64 * (j))
#define XB_XGEN(j)  (2304 + 64 * (j))
#define XB_TOP      3328
#define XB_TOPGEN   3392
#define XB_SLOT(b)  (4096 + 2 * (b))
#define XB_SPIN_CAP (1u << 20)
constexpr size_t CTL_ZERO_BYTES = 32768;
DEVI unsigned xb_ld(unsigned* p)              { return __hip_atomic_load(p, __ATOMIC_RELAXED, __HIP_MEMORY_SCOPE_AGENT); }
DEVI unsigned xb_add(unsigned* p, unsigned v) { return __hip_atomic_fetch_add(p, v, __ATOMIC_RELAXED, __HIP_MEMORY_SCOPE_AGENT); }
DEVI unsigned xb_xcc_id() { return (unsigned)__builtin_amdgcn_s_getreg((3 << 11) | 20) & 0xFu; }
#define XB_SPIN(cond, bar) do { unsigned _sp = 0; while (cond) { __builtin_amdgcn_s_sleep(1); \
    if ((++_sp & 255u) == 0u) { if (xb_ld(&(bar)[XB_TMO])) break; if (_sp > XB_SPIN_CAP) { atomicAdd(&(bar)[XB_TMO], 1u); break; } } } } while (0)
DEVI void xcd_barrier_complete(unsigned* bar, unsigned x, unsigned& nloc, unsigned& nx) {
    const unsigned G = gridDim.x * gridDim.y * gridDim.z;
    unsigned sum, cnt, mine, sp = 0u;
    for (;;) {
        sum = 0u; cnt = 0u; mine = 0u;
#pragma unroll
        for (unsigned j = 0; j < 16; ++j) { const unsigned c = xb_ld(&bar[XB_XCNT(j)]); sum += c; cnt += (c > 0u) ? 1u : 0u; mine = (j == x) ? c : mine; }
        if (sum == G) break;
        __builtin_amdgcn_s_sleep(1);
        if ((++sp & 255u) == 0u) { if (xb_ld(&bar[XB_TMO])) break; if (sp > XB_SPIN_CAP) { atomicAdd(&bar[XB_TMO], 1u); break; } }
    }
    nloc = mine > 0u ? mine : 1u; nx = cnt > 0u ? cnt : 1u;
}
DEVI void xcd_barrier(unsigned* bar, bool tid0) {
    asm volatile("s_waitcnt vmcnt(0)" ::: "memory");
    __syncthreads();
    if (tid0) {
        __builtin_amdgcn_s_waitcnt(0);
        const unsigned x = xb_xcc_id();
        volatile unsigned* st = bar + XB_SLOT(blockIdx.x);
        unsigned nloc = st[0], nx = st[1];
        if (nloc == 0u) { xcd_barrier_complete(bar, x, nloc, nx); st[0] = nloc; st[1] = nx; }
        const unsigned old = xb_add(&bar[XB_XSUB(x)], 1u);
        const unsigned gen = old / nloc;
        if (old + 1u == (gen + 1u) * nloc) {
            __builtin_amdgcn_fence(__ATOMIC_RELEASE, "agent");
            asm volatile("s_waitcnt vmcnt(0)" ::: "memory");
            const unsigned og = xb_add(&bar[XB_TOP], 1u);
            const unsigned tg = og / nx;
            if (og + 1u == (tg + 1u) * nx) xb_add(&bar[XB_TOPGEN], 1u);
            else XB_SPIN(xb_ld(&bar[XB_TOPGEN]) == tg, bar);
            __builtin_amdgcn_fence(__ATOMIC_ACQUIRE, "agent");
            xb_add(&bar[XB_XGEN(x)], 1u);
            asm volatile("s_waitcnt vmcnt(0)" ::: "memory");
        } else {
            XB_SPIN(xb_ld(&bar[XB_XGEN(x)]) == gen, bar);
            __builtin_amdgcn_fence(__ATOMIC_ACQUIRE, "agent");
            asm volatile("s_waitcnt vmcnt(0)" ::: "memory");
        }
    }
    __syncthreads();
}

DEVI void group_sync(unsigned* bar, unsigned* ctr, unsigned target, bool tid0) {
    asm volatile("s_waitcnt vmcnt(0)" ::: "memory");
    __syncthreads();
    if (tid0) {
        __builtin_amdgcn_s_waitcnt(0);
        xb_add(ctr, 1u);
        XB_SPIN(xb_ld(ctr) < target, bar);
        __builtin_amdgcn_fence(__ATOMIC_ACQUIRE, "agent");
        asm volatile("s_waitcnt vmcnt(0)" ::: "memory");
    }
    __syncthreads();
}

struct EpiResFinalMK {
    static constexpr bool PERM = true, AFTER_DRAIN = true, PROBE_DBL = false;
    const float* xin; float* out; const float* gf; float* SSQ; unsigned* bar; unsigned* gctr; unsigned gtarget;
    DEVI void fused(f32x4 (&acc)[2][2][4][2], const pg8::Unit& u, int wr, int wc, int fr, int fq, LAS unsigned char*, int wid, int lane) const {
        const int row0 = u.pm * 256 + wr * 64 + fr, col0 = u.pn * 256 + wc * 32 + 8 * fq;
#pragma unroll
        for (int ai = 0; ai < 2; ++ai)
#pragma unroll
        for (int mh = 0; mh < 2; ++mh) {
            f32x4 xr[2][2][2];
#pragma unroll
            for (int mm = 0; mm < 2; ++mm)
#pragma unroll
                for (int bj = 0; bj < 2; ++bj) { const size_t o = (size_t)(row0 + ai * 128 + (2 * mh + mm) * 16) * 1024 + col0 + bj * 128; xr[mm][bj][0] = *(const f32x4*)(xin + o); xr[mm][bj][1] = *(const f32x4*)(xin + o + 4); }
#pragma unroll
            for (int mm = 0; mm < 2; ++mm) {
                const int m = 2 * mh + mm;
                const int row = row0 + ai * 128 + m * 16;
                float s = 0.f;
#pragma unroll
                for (int bj = 0; bj < 2; ++bj) {
                    const f32x4 y0 = xr[mm][bj][0] + acc[ai][bj][m][0], y1 = xr[mm][bj][1] + acc[ai][bj][m][1];
                    acc[ai][bj][m][0] = y0; acc[ai][bj][m][1] = y1;
                    s += (y0[0] * y0[0] + y0[1] * y0[1]) + (y0[2] * y0[2] + y0[3] * y0[3]) + (y1[0] * y1[0] + y1[1] * y1[1]) + (y1[2] * y1[2] + y1[3] * y1[3]);
                }
                { const int ln = fq * 16 + fr; s += bperm_xor(s, ln, 16); s += bperm_xor(s, ln, 32); }
                if (fq == 0) SSQ[(size_t)row * 16 + u.pn * 4 + wc] = s;
            }
            asm volatile("" ::: "memory");
        }
        if (gctr) group_sync(bar, gctr, gtarget, wid == 0 && lane == 0); else xcd_barrier(bar, wid == 0 && lane == 0);
        f32x4 gv[2][2];
#pragma unroll
        for (int bj = 0; bj < 2; ++bj) { gv[bj][0] = *(const f32x4*)(gf + col0 + bj * 128); gv[bj][1] = *(const f32x4*)(gf + col0 + bj * 128 + 4); }
#pragma unroll
        for (int ai = 0; ai < 2; ++ai)
#pragma unroll
            for (int m = 0; m < 4; ++m) {
                const int row = row0 + ai * 128 + m * 16; const float rs = rstd_of(SSQ, row);
#pragma unroll
                for (int bj = 0; bj < 2; ++bj) {
                    const size_t o = (size_t)row * 1024 + col0 + bj * 128;
                    *(f32x4*)(out + o) = acc[ai][bj][m][0] * rs * gv[bj][0]; *(f32x4*)(out + o + 4) = acc[ai][bj][m][1] * rs * gv[bj][1];
                }
            }
    }
};

namespace dsa {
typedef short bf16x8 __attribute__((ext_vector_type(8)));
typedef short s16x4 __attribute__((ext_vector_type(4)));
typedef float f32x4 __attribute__((ext_vector_type(4)));
typedef unsigned u32x4 __attribute__((ext_vector_type(4)));
typedef __attribute__((address_space(3))) unsigned lds_u32;
typedef __attribute__((address_space(3))) unsigned short lds_u16;
typedef __attribute__((address_space(3))) unsigned char lds_u8;
constexpr int WAVE_LDS = 16384;
constexpr int OFF_SEL = 14336;
constexpr int OFF_STG = 8 * WAVE_LDS;
constexpr int STG_BYTES = 16384;
constexpr int DSA_LDS = OFF_STG + 2 * STG_BYTES;
constexpr int VROW = 144;

DEVI int bperm_i(int v, int srclane) { return __builtin_amdgcn_ds_bpermute(srclane << 2, v); }

DEVI void chunk_scores(unsigned (&u)[4], const bf16x8 (&bfr)[4][2], const bf16x8& a0, const bf16x8& a1, const f32x4& w) {
    f32x4 cc[4];
#pragma unroll
    for (int t = 0; t < 4; ++t) cc[t] = __builtin_amdgcn_mfma_f32_16x16x32_bf16(a0, bfr[t][0], (f32x4){0.f, 0.f, 0.f, 0.f}, 0, 0, 0);
#pragma unroll
    for (int t = 0; t < 4; ++t) cc[t] = __builtin_amdgcn_mfma_f32_16x16x32_bf16(a1, bfr[t][1], cc[t], 0, 0, 0);
#pragma unroll
    for (int t = 0; t < 4; ++t) {
        const f32x4 c = cc[t];
        float r0, r1, r2, r3;
        { int i0_ = __float_as_int(c[0]), i1_ = __float_as_int(c[1]), i2_ = __float_as_int(c[2]), i3_ = __float_as_int(c[3]);
          r0 = __int_as_float(i0_ > 0 ? i0_ : 0); r1 = __int_as_float(i1_ > 0 ? i1_ : 0); r2 = __int_as_float(i2_ > 0 ? i2_ : 0); r3 = __int_as_float(i3_ > 0 ? i3_ : 0); }
        float s = fmaf(w[0], r0, 0.0f); s = fmaf(w[1], r1, s); s = fmaf(w[2], r2, s); s = fmaf(w[3], r3, s);
        const int b = __float_as_int(s);
        u[t] = (unsigned)(b ^ ((b >> 31) | (int)0x80000000));
    }
}
#if defined(DSA_STAMP)
__device__ unsigned long long g_dsa_stamp = 0ull;
#define DSA_CLK() ((unsigned long long)__builtin_readcyclecounter())
#endif
constexpr unsigned CAND_CAP = 597u;
DEVI unsigned kbin(unsigned u) {
    const bool pos = (int)u < 0;
    const unsigned x = pos ? u : ~u;
    int m = (int)(x >> 19) - 5632; m = m < 0 ? 0 : m;
    const int mp = m > 1022 ? 1022 : m, mn = m > 1023 ? 1023 : m;
    return (u == 0x80000000u) ? 1024u : (pos ? (unsigned)(1025 + mp) : (unsigned)(1023 - mn));
}
struct PassState { unsigned prefix, T, need, cnt, eqc; unsigned mode; lds_u16* aux;
#if defined(DSA_STAMP)
    unsigned long long* pacc;
#endif
};
DEVI void lds_store2_masked(unsigned long long mask, unsigned addr_u, unsigned uval, unsigned addr_k, unsigned key) {
    unsigned long long sv;
    asm volatile("s_and_saveexec_b64 %0, %1\n\tds_write_b32 %2, %3\n\tds_write_b16 %4, %5\n\ts_mov_b64 exec, %0"
                 : "=&s"(sv) : "s"(mask), "v"(addr_u), "v"(uval), "v"(addr_k), "v"(key) : "memory", "scc");
}
template <bool ALLV>
DEVI void chunk_cand(const unsigned (&u)[4], int kc, int qpos, int g, int n16, lds_u32* cu, lds_u16* sel, PassState& st) {
    const unsigned below = (1u << n16) - 1u;
    const unsigned cub = (unsigned)(size_t)cu, ckb = (unsigned)(size_t)st.aux;
    unsigned long long mk[4];
#pragma unroll
    for (int t = 0; t < 4; ++t) {
        const int key = kc + t * 16 + n16;
        mk[t] = ALLV ? __builtin_amdgcn_uicmp(u[t], st.T, 35  ) : __builtin_amdgcn_ballot_w64(u[t] >= st.T && key <= qpos);
    }
    unsigned cnt = st.cnt;
#pragma unroll
    for (int t = 0; t < 4; ++t) {
        const int key = kc + t * 16 + n16;
        const unsigned mg = (unsigned)(mk[t] >> (16 * g));
        unsigned pc = cnt + (unsigned)__popc(mg & below);
        pc = pc < CAND_CAP - 1u ? pc : CAND_CAP - 1u;
        lds_store2_masked(mk[t], cub + 4u * pc, u[t], ckb + 2u * pc, (unsigned)key);
        cnt += (unsigned)__popc(mg & 0xffffu);
    }
    st.cnt = cnt;
    if (st.need) {
#pragma unroll
        for (int t = 0; t < 4; ++t) {
            const int key = kc + t * 16 + n16; const bool valid = ALLV ? true : (key <= qpos);
            const bool zdir = valid && st.mode && (u[t] == 0x80000000u);
            const unsigned mz = (unsigned)(__builtin_amdgcn_ballot_w64(zdir) >> (16 * g)) & 0xffffu;
            const unsigned pz = st.eqc + (unsigned)__popc(mz & below);
            if (zdir && pz < 256u) sel[pz] = (unsigned short)key;
            st.eqc += (unsigned)__popc(mz);
        }
    }
}
template <int PASS, bool ALLV>
DEVI void chunk_work(const unsigned (&u)[4], int kc, int qpos, int g, int n16, lds_u32* hist, lds_u16* sel, PassState& st) {
    if constexpr (PASS == 8) { chunk_cand<ALLV>(u, kc, qpos, g, n16, hist, sel, st); return; }
    const unsigned below = (1u << n16) - 1u;
#pragma unroll
    for (int t = 0; t < 4; ++t) {
        const int key = kc + t * 16 + n16; const bool valid = ALLV ? true : (key <= qpos);
        if (PASS == 7) { const unsigned bn = kbin(u[t]); __hip_atomic_fetch_add(hist + (bn >> 1), valid ? (1u << (16 * (bn & 1u))) : 0u, __ATOMIC_RELAXED, __HIP_MEMORY_SCOPE_WORKGROUP); }
        else if (PASS == 8) {
            const bool cand = valid && u[t] >= st.T;
            const unsigned long long mc64 = ALLV ? __builtin_amdgcn_uicmp(u[t], st.T, 35  ) : (__builtin_amdgcn_ballot_w64(u[t] >= st.T) & __builtin_amdgcn_ballot_w64(valid));
            const unsigned mc = (unsigned)(mc64 >> (16 * g)) & 0xffffu;
            const unsigned pc = st.cnt + (unsigned)__popc(mc & below);
            if (cand && pc < CAND_CAP) { hist[pc] = u[t]; st.aux[pc] = (unsigned short)key; }
            st.cnt += (unsigned)__popc(mc);
            if (st.need) {
                const bool zdir = valid && st.mode && (u[t] == 0x80000000u);
                const unsigned mz = (unsigned)(__builtin_amdgcn_ballot_w64(zdir) >> (16 * g)) & 0xffffu;
                const unsigned pz = st.eqc + (unsigned)__popc(mz & below);
                if (zdir && pz < 256u) sel[pz] = (unsigned short)key;
                st.eqc += (unsigned)__popc(mz);
            }
        }
        else if (PASS == 1) { const unsigned bn = u[t] >> 21; __hip_atomic_fetch_add(hist + (bn >> 1), valid ? (1u << (16 * (bn & 1u))) : 0u, __ATOMIC_RELAXED, __HIP_MEMORY_SCOPE_WORKGROUP); }
        else if (PASS == 2) { if (valid && (u[t] >> 21) == st.prefix) { const unsigned bn = (u[t] >> 10) & 0x7ffu; __hip_atomic_fetch_add(hist + (bn >> 1), 1u << (16 * (bn & 1u)), __ATOMIC_RELAXED, __HIP_MEMORY_SCOPE_WORKGROUP); } }
        else if (PASS == 3) { if (valid && (u[t] >> 10) == st.prefix) { const unsigned bn = u[t] & 0x3ffu; __hip_atomic_fetch_add(hist + (bn >> 1), 1u << (16 * (bn & 1u)), __ATOMIC_RELAXED, __HIP_MEMORY_SCOPE_WORKGROUP); } }
        else if (PASS == 4) {
            const bool take = valid && u[t] > st.T;
            const unsigned msel = (unsigned)((__builtin_amdgcn_ballot_w64(u[t] > st.T) & __builtin_amdgcn_ballot_w64(valid)) >> (16 * g)) & 0xffffu;
            const unsigned pos = st.cnt + (unsigned)__popc(msel & below);
            if (take && pos < 256u) sel[pos] = (unsigned short)key;
            st.cnt += (unsigned)__popc(msel);
        } else {
            const bool gt = valid && u[t] > st.T, eq = valid && u[t] == st.T;
            const unsigned meq = (unsigned)(__builtin_amdgcn_ballot_w64(eq) >> (16 * g)) & 0xffffu;
            const bool take = gt || (eq && (st.eqc + (unsigned)__popc(meq & below)) < st.need);
            const unsigned msel = (unsigned)(__builtin_amdgcn_ballot_w64(take) >> (16 * g)) & 0xffffu;
            const unsigned pos = st.cnt + (unsigned)__popc(msel & below);
            if (take && pos < 256u) sel[pos] = (unsigned short)key;
            st.cnt += (unsigned)__popc(msel); st.eqc += (unsigned)__popc(meq);
        }
    }
}
template <int PASS, int STRIDE>
DEVI void run_pass_blk(const bf16_t* IKb, int nst, int tid, int lane, const bf16x8& a0, const bf16x8& a1, const f32x4& w, int qpos, int qmaxw, lds_u32* hist, lds_u16* sel, PassState& st, lds_u8* stg) {
    const int g = lane >> 4, n16 = lane & 15;
    const int srow = tid >> 3, sch = tid & 7;
#if defined(DSA_STAMP)
    const bool stamp_on = (PASS == DSA_STAMP_PASS) && (blockIdx.x == DSA_STAMP_BLK) && (__builtin_amdgcn_readfirstlane(tid >> 6) == DSA_STAMP_WAVE);
    unsigned long long stacc = 0ull, stt = 0ull;
    if (DSA_STAMP == 2 && stamp_on) stt = DSA_CLK();
#endif
    const bf16_t* gp = IKb + (size_t)srow * 64 + sch * 8;
    const int woff = srow * 128 + ((sch ^ ((srow >> 1) & 7)) << 4);
    const int sw = (n16 >> 1) & 7;
    const int roff0 = n16 * 128 + ((g ^ sw) << 4), roff1 = n16 * 128 + (((g + 4) ^ sw) << 4);
#define DSA_LOAD(RA, RB, st_) do { const int s_ = ((st_) < nst) ? (st_) : nst - 1; const bf16_t* gn = gp + (size_t)s_ * (STRIDE * 128 * 64); RA = *(const u32x4*)gn; RB = *(const u32x4*)(gn + 64 * 64); } while (0)
#define DSA_WRITE(RA, RB, bufoff) do { *(__attribute__((address_space(3))) u32x4*)(stg + (bufoff) + woff) = RA; *(__attribute__((address_space(3))) u32x4*)(stg + (bufoff) + 8192 + woff) = RB; } while (0)
#if defined(DSA_STAMP)
#define DSA_STAMP3() do { if (DSA_STAMP == 3 && stamp_on) { asm volatile("s_waitcnt lgkmcnt(0)" ::: "memory"); stacc += DSA_CLK() - stt; } } while (0)
#else
#define DSA_STAMP3() do { } while (0)
#endif
#define DSA_COMPUTE(st_, bufoff) do { bf16x8 bfr[2][4][2];                   \
        _Pragma("unroll") for (int h = 0; h < 2; ++h) _Pragma("unroll") for (int t = 0; t < 4; ++t) { \
            bfr[h][t][0] = *(const __attribute__((address_space(3))) bf16x8*)(stg + (bufoff) + h * 8192 + t * 2048 + roff0); \
            bfr[h][t][1] = *(const __attribute__((address_space(3))) bf16x8*)(stg + (bufoff) + h * 8192 + t * 2048 + roff1); } \
        __builtin_amdgcn_sched_barrier(0); DSA_STAMP3(); \
        const int kc0_ = (st_) * (STRIDE * 128); \
        if ((PASS == 7 || PASS == 8) && kc0_ + 127 <= qmaxw - 3) {        \
            unsigned u0_[4], u1_[4]; chunk_scores(u0_, bfr[0], a0, a1, w); chunk_scores(u1_, bfr[1], a0, a1, w); \
            chunk_work<PASS, true>(u0_, kc0_, qpos, g, n16, hist, sel, st); chunk_work<PASS, true>(u1_, kc0_ + 64, qpos, g, n16, hist, sel, st); \
        } else { \
        _Pragma("unroll") for (int h = 0; h < 2; ++h) { const int kc = kc0_ + h * 64; if (kc <= qmaxw) { \
            unsigned u[4]; chunk_scores(u, bfr[h], a0, a1, w); \
            if ((PASS == 7 || PASS == 8) && kc + 63 <= qmaxw - 3) chunk_work<PASS, true>(u, kc, qpos, g, n16, hist, sel, st); else chunk_work<PASS, false>(u, kc, qpos, g, n16, hist, sel, st); } } } } while (0)
#if defined(DSA_STAMP)
#define DSA_BAR() do { asm volatile("s_waitcnt lgkmcnt(0)" ::: "memory"); unsigned long long tb_ = 0ull; if (DSA_STAMP == 1 && stamp_on) tb_ = DSA_CLK(); __builtin_amdgcn_s_barrier(); \
        if (DSA_STAMP == 1 && stamp_on) stacc += DSA_CLK() - tb_; if (DSA_STAMP == 3 && stamp_on) stt = DSA_CLK(); } while (0)
#else
#define DSA_BAR() do { asm volatile("s_waitcnt lgkmcnt(0)" ::: "memory"); __builtin_amdgcn_s_barrier(); } while (0)
#endif
    u32x4 p0, p1, q0r, q1r;
    DSA_LOAD(p0, p1, 0); DSA_WRITE(p0, p1, 0); DSA_LOAD(q0r, q1r, 1);
    DSA_BAR();
    for (int s = 0; s < nst; s += 2) {
        DSA_LOAD(p0, p1, s + 2);
        DSA_COMPUTE(s, 0);
        DSA_WRITE(q0r, q1r, STG_BYTES);
        DSA_BAR();
        {
            DSA_LOAD(q0r, q1r, s + 3);
            DSA_COMPUTE(s + 1, STG_BYTES);
            DSA_WRITE(p0, p1, 0);
            DSA_BAR();
        }
    }
#undef DSA_LOAD
#undef DSA_WRITE
#undef DSA_COMPUTE
#undef DSA_BAR
#undef DSA_STAMP3
#if defined(DSA_STAMP)
    if (DSA_STAMP == 2 && stamp_on) stacc = DSA_CLK() - stt;
    if (stamp_on && lane == 0) atomicAdd(st.pacc, stacc >> 4);
#endif
}
DEVI void scan_level(lds_u32* hist, int wpl, unsigned K, int lane, unsigned& bin, unsigned& Knew, unsigned& cbin, unsigned fracn = 0u) {
    const int i = lane & 15, g = lane >> 4;
    const lds_u32* hw = hist + i * wpl;
    const int spb = wpl >> 3;
    unsigned sb[8]; unsigned sum = 0u;
#pragma unroll
    for (int q = 0; q < 8; ++q) {
        unsigned s = 0u;
        for (int x = 0; x < spb; x += 4) { const u32x4 v = *(const __attribute__((address_space(3))) u32x4*)(hw + q * spb + x); s += (v.x & 0xffffu) + (v.x >> 16) + (v.y & 0xffffu) + (v.y >> 16) + (v.z & 0xffffu) + (v.z >> 16) + (v.w & 0xffffu) + (v.w >> 16); }
        sb[q] = s; sum += s;
    }
    unsigned suf = sum;
#pragma unroll
    for (int off = 1; off < 16; off <<= 1) { const unsigned t = (unsigned)bperm_i((int)suf, lane + off); if (i + off < 16) suf += t; }
    if (fracn) { const unsigned tot = (unsigned)bperm_i((int)suf, 16 * g); K = (tot * 380u + fracn - 1u) / fracn; K = K ? K : 1u; }
    const unsigned above = suf - sum;
    const bool found = (above < K && K <= suf);
    unsigned b = 0u, kn = 0u, cb = 0u;
    if (found) {
        unsigned cum = above; int qs = 0;
#pragma unroll
        for (int q = 7; q >= 0; --q) { if (qs == 0 && cum + sb[q] >= K) qs = q + 1; if (qs == 0) cum += sb[q]; }
        const int w0 = (qs - 1) * spb;
        for (int wi = w0 + spb - 1; wi >= w0; --wi) {
            const unsigned v = hw[wi]; const unsigned hi = v >> 16, lo = v & 0xffffu;
            if (cum + hi >= K) { b = (unsigned)(2 * (i * wpl + wi) + 1); kn = K - cum; cb = hi; break; }
            cum += hi;
            if (cum + lo >= K) { b = (unsigned)(2 * (i * wpl + wi)); kn = K - cum; cb = lo; break; }
            cum += lo;
        }
    }
    const unsigned gm = (unsigned)(__builtin_amdgcn_ballot_w64(found) >> (16 * g)) & 0xffffu;
    const int src = 16 * g + (gm ? __ffs((int)gm) - 1 : 0);
    bin = (unsigned)bperm_i((int)b, src); Knew = (unsigned)bperm_i((int)kn, src); cbin = (unsigned)bperm_i((int)cb, src);
}
DEVI void zero_hist(lds_u8* wl, int lane) {
    const u32x4 z = {0u, 0u, 0u, 0u};
#pragma unroll
    for (int x = 0; x < 16; ++x) *(__attribute__((address_space(3))) u32x4*)(wl + (x * 64 + lane) * 16) = z;
    asm volatile("s_waitcnt lgkmcnt(0)" ::: "memory");
}
DEVI bool block_any(bool flag, lds_u8* stg, int tid) {
    lds_u32* vw = (lds_u32*)stg;
    if (tid == 0) vw[0] = 0u;
    asm volatile("s_waitcnt lgkmcnt(0)" ::: "memory"); __builtin_amdgcn_s_barrier();
    if (flag && (tid & 63) == 0) vw[0] = 1u;
    asm volatile("s_waitcnt lgkmcnt(0)" ::: "memory"); __builtin_amdgcn_s_barrier();
    const bool r = vw[0] != 0u;
    asm volatile("s_waitcnt lgkmcnt(0)" ::: "memory"); __builtin_amdgcn_s_barrier();
    return r;
}

DEVI unsigned gsum16d(unsigned v) {
    v += (unsigned)__builtin_amdgcn_update_dpp(0, (int)v, 0xB1, 0xF, 0xF, true);
    v += (unsigned)__builtin_amdgcn_update_dpp(0, (int)v, 0x4E, 0xF, 0xF, true);
    v += (unsigned)__builtin_amdgcn_update_dpp(0, (int)v, 0x141, 0xF, 0xF, true);
    v += (unsigned)__builtin_amdgcn_update_dpp(0, (int)v, 0x140, 0xF, 0xF, true);
    return v;
}
DEVI unsigned gsum16(unsigned v, int lane) { v += (unsigned)bperm_i((int)v, lane ^ 1); v += (unsigned)bperm_i((int)v, lane ^ 2); v += (unsigned)bperm_i((int)v, lane ^ 4); v += (unsigned)bperm_i((int)v, lane ^ 8); return v; }
DEVI unsigned xpre16(unsigned v, int lane) {
    const int i = lane & 15; unsigned s = v;
#pragma unroll
    for (int off = 1; off < 16; off <<= 1) { const unsigned t = (unsigned)bperm_i((int)s, lane - off); if (i >= off) s += t; }
    return s - v;
}
DEVI void resolve_cands(const lds_u32* cu, const lds_u16* ck, unsigned c, lds_u16* sel, int lane) {
    const int i = lane & 15;
    const unsigned per = (c + 15u) >> 4;
    const unsigned j0 = (i * per < c) ? i * per : c, j1 = (j0 + per < c) ? j0 + per : c;
    unsigned cr[38];
#pragma unroll
    for (int x = 0; x < 38; ++x) cr[x] = (j0 + x < j1) ? cu[j0 + x] : 0u;
    unsigned prefix = 0u;
#pragma unroll 1
    for (int bit = 31; bit >= 0; --bit) {
        const unsigned trial = prefix | (1u << bit); unsigned cnt = 0u;
#pragma unroll
        for (int x = 0; x < 38; ++x) cnt += (cr[x] >= trial) ? 1u : 0u;
        if (gsum16d(cnt) >= 256u) prefix = trial;
    }
    const unsigned T = prefix;
    unsigned gtl = 0u, eql = 0u;
#pragma unroll
    for (int x = 0; x < 38; ++x) { gtl += (cr[x] > T) ? 1u : 0u; eql += (cr[x] == T && j0 + x < j1) ? 1u : 0u; }
    const unsigned need = 256u - gsum16d(gtl);
    const unsigned eqb = xpre16(eql, lane);
    const unsigned teq = (eqb >= need) ? 0u : ((need - eqb < eql) ? need - eqb : eql);
    unsigned pos = xpre16(gtl + teq, lane), eqs = 0u;
#pragma unroll
    for (int x = 0; x < 38; ++x) {
        const bool in = j0 + x < j1;
        const bool tk = in && (cr[x] > T || (cr[x] == T && eqs < teq));
        if (in && cr[x] == T) ++eqs;
        if (tk) { if (pos < 256u) sel[pos] = ck[j0 + x]; ++pos; }
    }
}
DEVI void group(int b, int q0, const bf16_t* IQ, const bf16_t* IK, const float* IW, const bf16_t* AQ_O, bf16_t* OUT_O, const bf16_t* AK, const bf16_t* AV, lds_u8* wl, lds_u8* stg, int Q0, int tid, int lane) {
    const int g = lane >> 4, n16 = lane & 15;
    const size_t m0 = (size_t)b * SEQ + q0;
    lds_u32* hist = (lds_u32*)wl + g * 1024;
    lds_u16* sel = (lds_u16*)(wl + OFF_SEL) + g * 256;
    const int qpos = q0 + g;
    if (Q0 + 31 < 256) {
        for (int k = n16; k < 256; k += 16) sel[k] = (unsigned short)k;
    } else {
        const bf16_t* IKb = IK + (size_t)b * SEQ * 64;
        bf16x8 a0, a1; f32x4 w;
        { const bf16_t* pq = IQ + (m0 + (n16 >> 2)) * 256 + (n16 & 3) * 64 + 8 * g; a0 = *(const bf16x8*)pq; a1 = *(const bf16x8*)(pq + 32); w = *(const f32x4*)(IW + (m0 + g) * 4); }
        const int nst = (Q0 + 32 + 127) >> 7;
        unsigned K = 256u, bin = 0u, cb = 0u;
        PassState st; st.prefix = 0u; st.T = 0u; st.need = 0u; st.cnt = 0u; st.eqc = 0u; st.mode = 0u; st.aux = nullptr;
#if defined(DSA_STAMP)
        st.pacc = (unsigned long long*)((char*)const_cast<bf16_t*>(IK) - WS_IK + WS_CTL + 24576);
#endif
        bool need_exact = true;
        {
            lds_u32* cu = (lds_u32*)(wl + g * 3584); lds_u16* ck = (lds_u16*)(wl + g * 3584 + 2388);
            if (Q0 + 32 > (int)CAND_CAP) {
                zero_hist(wl, lane);
                run_pass_blk<7, 2>(IKb, (nst + 1) >> 1, tid, lane, a0, a1, w, qpos, q0 + 3, hist, sel, st, stg);
                unsigned kd = 0u, cbd = 0u;
                scan_level(hist, 64, 96u, lane, bin, kd, cbd, (unsigned)(qpos + 1));
            } else bin = 0u;
            PassState ss; ss.prefix = bin; ss.cnt = 0u; ss.eqc = 0u; ss.mode = (bin == 1024u) ? 1u : 0u; ss.aux = ck;
#if defined(DSA_STAMP)
            ss.pacc = st.pacc;
#endif
            ss.T = (bin >= 1026u) ? ((4607u + bin) << 19) : (bin >= 1024u) ? 0x80000001u : (bin == 0u) ? 0u : ~(((6656u - bin) << 19) - 1u);
            ss.need = __any(ss.mode != 0u) ? 1u : 0u;
#if defined(DSA_DBL_P8)
            run_pass_blk<8, 1>(IKb, nst, tid, lane, a0, a1, w, qpos, q0 + 3, cu, sel, ss, stg); ss.cnt = 0u; ss.eqc = 0u;
#endif
            run_pass_blk<8, 1>(IKb, nst, tid, lane, a0, a1, w, qpos, q0 + 3, cu, sel, ss, stg);
            const unsigned c = ss.cnt, z = ss.eqc;
            const bool zfill = ss.mode && c < 256u;
            const bool bad = (c > CAND_CAP) || (zfill ? (c + z < 256u) : (c < 256u));
            need_exact = block_any(__any(bad), stg, tid);
#if defined(DSA_NOFALLBACK)
            need_exact = false;
#endif
            if (!need_exact) {
                if (zfill) { for (unsigned x = (unsigned)n16; x < c; x += 16u) sel[256u - c + x] = ck[x]; }
                else {
#if defined(DSA_DBL_RES)
                    resolve_cands(cu, ck, c, sel, lane);
#endif
                    resolve_cands(cu, ck, c, sel, lane); }
            }
        }
        if (need_exact) {
#if defined(DSA_DBL_P1)
        zero_hist(wl, lane);
        run_pass_blk<1, 1>(IKb, nst, tid, lane, a0, a1, w, qpos, q0 + 3, hist, sel, st, stg);
#endif
        zero_hist(wl, lane);
        run_pass_blk<1, 1>(IKb, nst, tid, lane, a0, a1, w, qpos, q0 + 3, hist, sel, st, stg);
        scan_level(hist, 64, K, lane, bin, K, cb); st.prefix = bin;
#if defined(DSA_DBL_P2)
        zero_hist(wl, lane);
        run_pass_blk<2, 1>(IKb, nst, tid, lane, a0, a1, w, qpos, q0 + 3, hist, sel, st, stg);
#endif
        zero_hist(wl, lane);
        run_pass_blk<2, 1>(IKb, nst, tid, lane, a0, a1, w, qpos, q0 + 3, hist, sel, st, stg);
        scan_level(hist, 64, K, lane, bin, K, cb);
        const unsigned p22 = (st.prefix << 11) | bin;
        const bool done2 = (cb == K) && (p22 != 0u);
        if (done2) { st.T = (p22 << 10) - 1u; st.need = 0u; st.prefix = 0xffffffffu; } else { st.prefix = p22; }
        if (block_any(__any(!done2), stg, tid)) {
            zero_hist(wl, lane);
            run_pass_blk<3, 1>(IKb, nst, tid, lane, a0, a1, w, qpos, q0 + 3, hist, sel, st, stg);
            if (!done2) {
                scan_level(hist, 32, K, lane, bin, K, cb);
                st.T = (p22 << 10) | bin; st.need = K;
                if (cb == K && st.T != 0u) { st.T -= 1u; st.need = 0u; }
            }
        }
        if (block_any(__any(st.need != 0u), stg, tid)) run_pass_blk<5, 1>(IKb, nst, tid, lane, a0, a1, w, qpos, q0 + 3, hist, sel, st, stg);
        else run_pass_blk<4, 1>(IKb, nst, tid, lane, a0, a1, w, qpos, q0 + 3, hist, sel, st, stg);
        }
    }
    asm volatile("s_waitcnt lgkmcnt(0)" ::: "memory");
    const bf16_t* AKb = AK + (size_t)b * SEQ * 64; const bf16_t* AVb = AV + (size_t)b * SEQ * 64;
    const lds_u16* selw = (const lds_u16*)(wl + OFF_SEL);
#if defined(DSA_DBL_ATT)
#define DSA_NJ 8
#else
#define DSA_NJ 4
#endif
#pragma unroll 1
    for (int jl = 0; jl < DSA_NJ; ++jl) {
        int j = jl & 3; asm volatile("" : "+s"(j));
        const int qp = q0 + j; const int cntj = (qp + 1 < 256) ? qp + 1 : 256;
        const lds_u16* sj = selw + j * 256;
        bf16x8 qf0 = {0, 0, 0, 0, 0, 0, 0, 0}, qf1 = qf0;
        if (n16 < 8) { const bf16_t* pq = AQ_O + (m0 + j) * 512 + n16 * 64 + 8 * g; qf0 = *(const bf16x8*)pq; qf1 = *(const bf16x8*)(pq + 32); }
        u32x4 vr[2][8];
#define DSA_VLOAD(c_, buf_) do { _Pragma("unroll") for (int e = 0; e < 8; ++e) { const int pos_ = 64 * (c_) + e * 8 + (lane >> 3); const int key_ = (pos_ < cntj) ? (int)sj[pos_] : 0; \
            vr[buf_][e] = *(const u32x4*)(AVb + (size_t)key_ * 64 + (lane & 7) * 8); } } while (0)
        DSA_VLOAD(0, 0);
        f32x4 sc[16];
#pragma unroll
        for (int hf = 0; hf < 2; ++hf) {
            bf16x8 kf[8][2];
#pragma unroll
            for (int t = 0; t < 8; ++t) {
                const int pos = 16 * (8 * hf + t) + n16; const int key = (pos < cntj) ? (int)sj[pos] : 0;
                const bf16_t* pk = AKb + (size_t)key * 64 + 8 * g;
                kf[t][0] = *(const bf16x8*)pk; kf[t][1] = *(const bf16x8*)(pk + 32);
            }
#pragma unroll
            for (int t = 0; t < 8; ++t) {
                f32x4 c = {0.f, 0.f, 0.f, 0.f};
                c = __builtin_amdgcn_mfma_f32_16x16x32_bf16(kf[t][0], qf0, c, 0, 0, 0);
                c = __builtin_amdgcn_mfma_f32_16x16x32_bf16(kf[t][1], qf1, c, 0, 0, 0);
                sc[8 * hf + t] = c;
            }
        }
        float mx = -INFINITY;
#pragma unroll
        for (int t = 0; t < 16; ++t)
#pragma unroll
            for (int r = 0; r < 4; ++r) { if (16 * t + 4 * g + r >= cntj) sc[t][r] = -INFINITY; mx = fmaxf(mx, sc[t][r]); }
        mx = fmaxf(mx, bperm_xor(mx, lane, 16)); mx = fmaxf(mx, bperm_xor(mx, lane, 32));
        float sum = 0.f;
#pragma unroll
        for (int t = 0; t < 16; ++t)
#pragma unroll
            for (int r = 0; r < 4; ++r) { sc[t][r] = __builtin_amdgcn_exp2f(sc[t][r] - mx); sum += sc[t][r]; }
        sum += bperm_xor(sum, lane, 16); sum += bperm_xor(sum, lane, 32);
        const float inv = 1.0f / sum;
        unsigned pkp[16][2];
#pragma unroll
        for (int t = 0; t < 16; ++t) { pkp[t][0] = pk2(sc[t][0] * inv, sc[t][1] * inv); pkp[t][1] = pk2(sc[t][2] * inv, sc[t][3] * inv); }
        f32x4 o[4];
#pragma unroll
        for (int d = 0; d < 4; ++d) o[d] = (f32x4){0.f, 0.f, 0.f, 0.f};
#pragma unroll
        for (int c = 0; c < 4; ++c) {
            asm volatile("s_waitcnt lgkmcnt(0)" ::: "memory");
#pragma unroll
            for (int e = 0; e < 8; ++e) *(__attribute__((address_space(3))) u32x4*)(wl + (e * 8 + (lane >> 3)) * VROW + (lane & 7) * 16) = vr[c & 1][e];
            if (c < 3) DSA_VLOAD(c + 1, (c + 1) & 1);
            asm volatile("s_waitcnt lgkmcnt(0)" ::: "memory");
#pragma unroll
            for (int ks = 0; ks < 2; ++ks) {
                const int t0 = 4 * c + 2 * ks;
                bf16x8 pa; { u32x4 t4 = {pkp[t0][0], pkp[t0][1], pkp[t0 + 1][0], pkp[t0 + 1][1]}; pa = __builtin_bit_cast(bf16x8, t4); }
                const lds_u8* vb = wl + (32 * ks + 4 * g + (n16 >> 2)) * VROW + (n16 & 3) * 8;
#pragma unroll
                for (int d = 0; d < 4; ++d) {
                    const s16x4 lo = __builtin_bit_cast(s16x4, __builtin_amdgcn_ds_read_tr16_b64_v4i16((__attribute__((address_space(3))) s16x4*)(vb + d * 32)));
                    const s16x4 hi = __builtin_bit_cast(s16x4, __builtin_amdgcn_ds_read_tr16_b64_v4i16((__attribute__((address_space(3))) s16x4*)(vb + 16 * VROW + d * 32)));
                    const bf16x8 vf = {lo[0], lo[1], lo[2], lo[3], hi[0], hi[1], hi[2], hi[3]};
                    o[d] = __builtin_amdgcn_mfma_f32_16x16x32_bf16(pa, vf, o[d], 0, 0, 0);
                }
            }
        }
#undef DSA_VLOAD
        if (g < 2) {
            bf16_t* po = ((DSA_NJ == 8 && jl < 4) ? OUT_O + ((size_t)104 << 19) : OUT_O) + (m0 + j) * 512;
#pragma unroll
            for (int d = 0; d < 4; ++d)
#pragma unroll
                for (int r = 0; r < 4; ++r) po[(4 * g + r) * 64 + 16 * d + n16] = (bf16_t)(pk2(o[d][r], 0.f) & 0xffffu);
        }
    }
    asm volatile("s_waitcnt lgkmcnt(0)" ::: "memory");
}
}

#ifndef MK_DSA
#define MK_DSA 1
#endif
#ifndef MK_DBL
#define MK_DBL 0
#endif
enum { DBL_DSA = 0x200, DBL_SWA = 0x400 };
constexpr size_t WS_DUMMY = 176 * MiB;
struct MKArgs { const float* in[10]; float* out; unsigned char* ws; int l_lo, l_hi, pmask, fin; };
constexpr int MK_LDS = dsa::DSA_LDS;
#ifndef MK_EN
#define MK_EN 0x1ff
#endif
enum { PH_PREP = 1, PH_P1 = 2, PH_ATT1 = 4, PH_ATT2 = 8, PH_GATE = 16, PH_BRANCH = 32, PH_OUT = 64, PH_FF1 = 128, PH_FF2 = 256 };

#ifndef MK_WQ
#define MK_WQ 1
#endif
#ifndef MK_GROUPS
#define MK_GROUPS 1
#endif
#ifndef MK_POOL_GATE
#define MK_POOL_GATE 1
#endif
constexpr int P1_TILES = (M / 256) * (NPERM / 256), GATE_TILES = (M / 256) * (3072 / 256);
struct OneTile {
    int pm, pn;
    __device__ bool next(int i, pg8::Unit& u) const { if (i != 0) return false; u.pm = pm; u.pn = pn; u.ord = 0; return true; }
    DEVI void a_ready(const pg8::Unit&) const {}
    DEVI void done(const pg8::Unit&) const {}
};
struct GSched {
    pg8::StaticOrder S; int gm, pm, pn0, n;
    __device__ bool next(int i, pg8::Unit& u) const { if (!gm) return S.next(i, u); if (i >= n) return false; u.pm = pm; u.pn = pn0 + i; u.ord = i; return true; }
    DEVI void a_ready(const pg8::Unit&) const {}
    DEVI void done(const pg8::Unit&) const {}
};
constexpr size_t CTL_GRP = 20480;
constexpr int GRP_LDS = 139280;
#define MK_GRP_LOAD() const int gm_ = __builtin_amdgcn_readfirstlane(((LAS int*)(lds + GRP_LDS))[0]), gpm_ = __builtin_amdgcn_readfirstlane(((LAS int*)(lds + GRP_LDS))[1]), gj_ = __builtin_amdgcn_readfirstlane(((LAS int*)(lds + GRP_LDS))[2])
#define MK_GRP_SYNC(bi_) do { if (gm_) { KARGS(kg_); const int n_ = __builtin_amdgcn_readfirstlane(((LAS int*)(lds + GRP_LDS))[3]) + 1; \
        group_sync((unsigned*)(kg_->ws + WS_CTL), (unsigned*)(kg_->ws + WS_CTL + CTL_GRP) + 16 * gpm_, 4u * (unsigned)n_, MK_TID() == 0); if (MK_TID() == 0) ((LAS int*)(lds + GRP_LDS))[3] = n_; __syncthreads(); } else GRID_SYNC_I(bi_); } while (0)
constexpr int TR_I_IN = 16 * (NPERM / 32), TR_I_GATE = 16 * (3072 / 32), TR_I_BR = 8 * 32, TR_I_OUT = 16 * 32, TR_I_FF1 = 16 * 128, TR_I_FF2 = 64 * 32;
DEVI TrItem tr_decode(int it, int lane, const float* w_in, const float* w_br, const float* w_out, const float* w_ff1, const float* w_ff2, unsigned char* ws) {
    TrItem t; int r = it, kb, nb;
    if (r < TR_I_IN) { kb = r / (NPERM / 32); nb = r % (NPERM / 32); t.W = w_in; t.ldw = NIN; t.K = 1024; t.WT = (bf16_t*)(ws + WS_W + WO_IN); t.sc = win_src_col(32 * nb + (lane & 31)); }
    else if ((r -= TR_I_IN) < TR_I_GATE) { kb = r / 96; nb = r % 96; t.W = w_in; t.ldw = NIN; t.K = 1024; t.WT = (bf16_t*)(ws + WS_W + WO_GATE); t.sc = NPROJ + 32 * nb + (lane & 31); }
    else if ((r -= TR_I_GATE) < 3 * TR_I_BR) { const int br = r / TR_I_BR, q = r % TR_I_BR; kb = q / 32; nb = q % 32; t.W = w_br + (size_t)br * 512 * 1024; t.ldw = 1024; t.K = 512; t.WT = (bf16_t*)(ws + WS_W + WO_BR) + (size_t)br * 1024 * 512; t.sc = 32 * nb + (lane & 31); }
    else if ((r -= 3 * TR_I_BR) < TR_I_OUT) { kb = r / 32; nb = r % 32; t.W = w_out; t.ldw = 1024; t.K = 1024; t.WT = (bf16_t*)(ws + WS_W + WO_OUT); t.sc = 32 * nb + (lane & 31); }
    else if ((r -= TR_I_OUT) < TR_I_FF1) { kb = r / 128; nb = r % 128; t.W = w_ff1; t.ldw = DFF; t.K = 1024; t.WT = (bf16_t*)(ws + WS_W + WO_FF1); t.sc = 32 * nb + (lane & 31); }
    else { r -= TR_I_FF1; kb = r / 32; nb = r % 32; t.W = w_ff2; t.ldw = 1024; t.K = DFF; t.WT = (bf16_t*)(ws + WS_W + WO_FF2); t.sc = 32 * nb + (lane & 31); }
    t.k0 = 64 * kb; t.n0 = 32 * nb; return t;
}
typedef const __attribute__((address_space(4))) MKArgs* kargs_t;
#define KARGS(ka) kargs_t ka = (kargs_t)__builtin_amdgcn_kernarg_segment_ptr(); asm volatile("" : "+s"(ka))

__global__ void __launch_bounds__(512, 2) mk_fwd(MKArgs a_unused) {
    extern __shared__ __attribute__((aligned(16))) unsigned char lds_raw[];
    const int wave_s = __builtin_amdgcn_readfirstlane((int)threadIdx.x >> 6);
#define MK_TID() (wave_s * 64 + mk_lane_id())
    LAS unsigned char* lds = (LAS unsigned char*)lds_raw;
#if defined(MK_STAMP_SYNC)
#define GRID_SYNC_I(bi_) do { KARGS(kb_); const bool pr_ = (blockIdx.x == MK_STAMP_SYNC_BLK) && (MK_TID() == 0) && (((MK_STAMP_SYNC_MASK) >> bi_) & 1); unsigned long long ts0_ = 0; if (pr_) ts0_ = __builtin_amdgcn_s_memrealtime(); \
    xcd_barrier((unsigned*)(kb_->ws + WS_CTL), MK_TID() == 0); if (pr_) atomicAdd((unsigned long long*)(kb_->ws + WS_CTL + 24576), __builtin_amdgcn_s_memrealtime() - ts0_); } while (0)
#define GRID_SYNC() GRID_SYNC_I(31)
#else
#define GRID_SYNC() do { KARGS(kb_); xcd_barrier((unsigned*)(kb_->ws + WS_CTL), MK_TID() == 0); } while (0)
#define GRID_SYNC_I(bi_) GRID_SYNC()
#endif
#define PHASE_IDS() int tid = MK_TID(); asm volatile("" : "+v"(tid)); const int lane = tid & 63, wave = __builtin_amdgcn_readfirstlane(tid >> 6); (void)lane; (void)wave
    int l_lo, l_hi, pmask;
    { KARGS(ka); l_lo = ka->l_lo; l_hi = ka->l_hi; pmask = ka->pmask; }
    { KARGS(ka); if (MK_TID() == 0) { const unsigned r_ = xb_add((unsigned*)(ka->ws + WS_CTL) + XB_XCNT(xb_xcc_id()), 1u);
        ((unsigned*)(ka->ws + WS_CTL + 19456))[blockIdx.x] = r_; }
      if (ka->pmask == 0x7fffffff) cg::this_grid().sync(); }

#if defined(MK_XSYNC)
    for (int xs = 0; xs < MK_XSYNC; ++xs) GRID_SYNC();
#endif
    bool fin_done = false;
    for (int l = l_lo; l < l_hi; ++l) {
        for (int rep_ = 0; rep_ < ((MK_DBL & PH_PREP) ? 2 : 1); ++rep_)
        if ((MK_EN & PH_PREP) && (pmask & PH_PREP)) {
            KARGS(ka); unsigned char* ws = ka->ws; PHASE_IDS();
            const int G = gridDim.x, gw = blockIdx.x * 8 + wave, NGW = G * 8;
            LAS float* scr = (LAS float*)(lds + wave * 16384);
            const float* w_in = ka->in[2] + (size_t)l * DMODEL * NIN;
            const float* w_br = ka->in[4] + (size_t)l * 3 * 512 * 1024;
            const float* w_out = ka->in[5] + (size_t)l * 1024 * 1024;
            const float* w_ff1 = ka->in[7] + (size_t)l * DMODEL * DFF;
            const float* w_ff2 = ka->in[8] + (size_t)l * DFF * DMODEL;
            bf16_t* WIN = (bf16_t*)(ws + WS_W + WO_IN); bf16_t* WGATE = (bf16_t*)(ws + WS_W + WO_GATE); bf16_t* WBR = (bf16_t*)(ws + WS_W + WO_BR);
            bf16_t* WOUT = (bf16_t*)(ws + WS_W + WO_OUT); bf16_t* WFF1 = (bf16_t*)(ws + WS_W + WO_FF1); bf16_t* WFF2 = (bf16_t*)(ws + WS_W + WO_FF2);
            constexpr int I_IN = 16 * (NPERM / 32), I_GATE = 16 * (3072 / 32), I_BR = 8 * 32, I_OUT = 16 * 32, I_FF1 = 16 * 128, I_FF2 = 64 * 32;
            constexpr int NITEMS = MK_WQ ? I_IN + I_GATE : I_IN + I_GATE + 3 * I_BR + I_OUT + I_FF1 + I_FF2;
            {
                float va[32], vb[32];
                int it0 = gw;
                tr_load(tr_decode(it0 < NITEMS ? it0 : NITEMS - 1, lane, w_in, w_br, w_out, w_ff1, w_ff2, ws), va, lane);
                for (; it0 < NITEMS; it0 += 2 * NGW) {
                    const int it1 = it0 + NGW, it2 = it0 + 2 * NGW;
                    tr_load(tr_decode(it1 < NITEMS ? it1 : NITEMS - 1, lane, w_in, w_br, w_out, w_ff1, w_ff2, ws), vb, lane);
                    tr_store(tr_decode(it0, lane, w_in, w_br, w_out, w_ff1, w_ff2, ws), va, scr, lane);
                    tr_load(tr_decode(it2 < NITEMS ? it2 : NITEMS - 1, lane, w_in, w_br, w_out, w_ff1, w_ff2, ws), va, lane);
                    if (it1 < NITEMS) tr_store(tr_decode(it1, lane, w_in, w_br, w_out, w_ff1, w_ff2, ws), vb, scr, lane);
                }
            }
            { float* KMz = (float*)(ws + WS_KMEAN); for (int i = blockIdx.x * 512 + tid; i < 2 * 8 * 32 * 64; i += G * 512) KMz[i] = 0.f; }
            if (l == 0) {
                float* COS = (float*)(ws + WS_COS); float* SIN = (float*)(ws + WS_SIN);
                float* SSQ = (float*)(ws + WS_SSQ); bf16_t* XG = (bf16_t*)(ws + WS_XG);
                for (int i = blockIdx.x * 512 + tid; i < SEQ * 32; i += G * 512) sincos_tab(i, COS, SIN);
                const float* g1 = ka->in[1]; const float* x = ka->in[0];
                const float4* gr = (const float4*)g1;
                float4 gg[4];
#pragma unroll
                for (int j = 0; j < 4; ++j) gg[j] = gr[lane + 64 * j];
                for (int m0 = gw; m0 < M; m0 += 4 * NGW) {
                    float4 v[4][4];
#pragma unroll
                    for (int r = 0; r < 4; ++r) { const int m = (m0 + r * NGW < M) ? m0 + r * NGW : m0; const float4* xr = (const float4*)(x + (size_t)m * DMODEL);
#pragma unroll
                        for (int j = 0; j < 4; ++j) v[r][j] = xr[lane + 64 * j]; }
#pragma unroll
                    for (int r = 0; r < 4; ++r) { const int m = m0 + r * NGW; if (m < M) {
                        float s = 0.f;
#pragma unroll
                        for (int j = 0; j < 4; ++j) {
                            const float4 w = v[r][j];
                            s += (w.x * w.x + w.y * w.y) + (w.z * w.z + w.w * w.w);
                            u32x2 o; o.x = pk2(w.x * gg[j].x, w.y * gg[j].y); o.y = pk2(w.z * gg[j].z, w.w * gg[j].w);
                            *(u32x2*)(XG + (size_t)m * DMODEL + 4 * (lane + 64 * j)) = o;
                        }
                        s = wave_sum_l(s, lane);
                        if (lane < 16) SSQ[(size_t)m * 16 + lane] = (lane == 0) ? s : 0.f;
                    } }
                }
            }
            GRID_SYNC_I(0);
        }
        for (int rep_ = 0; rep_ < ((MK_DBL & PH_P1) ? 2 : 1); ++rep_)
        if ((MK_EN & PH_P1) && (pmask & PH_P1)) {
            KARGS(ka); unsigned char* ws = ka->ws;
            pg8::Gemm g{(const bf16_t*)(ws + WS_XG), (const bf16_t*)(ws + WS_W + WO_IN), M, NPERM, DMODEL}; pg8::StaticOrder S; S.init(M, NPERM, (int)gridDim.x, (int)blockIdx.x);
            fill_rstd_table(S, (const float*)(ws + WS_SSQ), lds, MK_TID());
            EpiProjMK E{(const LAS float*)(lds + RSTD_TAB_OFF), ws, (const float*)(ws + WS_COS), (const float*)(ws + WS_SIN)};
            pg8::gemm_phase<EpiProjMK, pg8::StaticOrder, true, true>(lds, g, S, E, MK_TID());
        }
        if ((MK_EN & PH_P1) && (pmask & PH_P1)) {
            KARGS(ka); unsigned char* ws = ka->ws;
            const int rem = MK_POOL_GATE ? P1_TILES % (int)gridDim.x : 0;
            if (rem != 0 && (int)blockIdx.x >= rem && (int)blockIdx.x - rem < GATE_TILES) {
                const int gt = (int)blockIdx.x - rem;
                pg8::Gemm g{(const bf16_t*)(ws + WS_XG), (const bf16_t*)(ws + WS_W + WO_GATE), M, 3072, DMODEL}; OneTile S{gt & 63, gt >> 6};
                fill_rstd_table(S, (const float*)(ws + WS_SSQ), lds, MK_TID());
                EpiActMK<0> E{(const LAS float*)(lds + RSTD_TAB_OFF), (void*)(ws + WS_GS), 3072};
                pg8::gemm_phase<EpiActMK<0>, OneTile, true, true>(lds, g, S, E, MK_TID());
            }
            GRID_SYNC_I(1);
        }
        if ((MK_EN & PH_ATT1) && (pmask & PH_ATT1)) {
            KARGS(ka); unsigned char* ws = ka->ws; PHASE_IDS();
            const int G = gridDim.x, gw = blockIdx.x * 8 + wave, NGW = G * 8;
#if MK_DSA
            {
                const bf16_t* IQ = (const bf16_t*)(ws + WS_IQ); const bf16_t* IK = (const bf16_t*)(ws + WS_IK); const float* IW = (const float*)(ws + WS_IW);
                bf16_t* AQ = (bf16_t*)(ws + WS_AQ); const bf16_t* AK = (const bf16_t*)(ws + WS_AK); const bf16_t* AV = (const bf16_t*)(ws + WS_AV);
                dsa::lds_u8* wl = (dsa::lds_u8*)lds + wave * dsa::WAVE_LDS;
                dsa::lds_u8* stg = (dsa::lds_u8*)lds + dsa::OFF_STG;
#pragma unroll 1
                for (int i2 = 2 * (int)blockIdx.x; i2 < 512; i2 += 2 * G) {
#pragma unroll 1
                    for (int k = 0; k < ((MK_DBL & DBL_DSA) ? 4 : 2); ++k) {
                        int bb = (i2 >> 1) & 1, QQ = (k & 1) ? 32 * (255 - (i2 >> 2)) : 32 * (i2 >> 2);
                        asm volatile("" : "+s"(bb), "+s"(QQ));
                        bf16_t* OO = ((MK_DBL & DBL_DSA) && k < 2) ? (bf16_t*)(ws + WS_DUMMY) : AQ;
                        dsa::group(bb, QQ + 4 * wave, IQ, IK, IW, AQ, OO, AK, AV, wl, stg, QQ, tid, lane);
                    }
                }
                __syncthreads();
            }
#endif
            {
                const int x = (int)blockIdx.x & 7;
                const int rem = MK_POOL_GATE ? P1_TILES % (int)gridDim.x : 0, ngs = rem ? (((int)gridDim.x - rem) < GATE_TILES ? ((int)gridDim.x - rem) : GATE_TILES) : 0;
                const int ngx = MK_POOL_GATE ? (GATE_TILES - ngs - x + 7) >> 3 : 0;
                constexpr int WQ_FIRST = TR_I_IN + TR_I_GATE, WQ_ITEMS = 3 * TR_I_BR + TR_I_OUT + TR_I_FF1 + TR_I_FF2, WQ_CH = 32;
                static_assert(WQ_ITEMS % (8 * WQ_CH) == 0, "chunks split evenly over the 8 queues");
                const int nwq = MK_WQ ? WQ_ITEMS / (8 * WQ_CH) : 0;
                const int total = 64 + ngx + 64 + nwq;
                unsigned* qc = (unsigned*)(ws + WS_CTL + 28672) + (l * 8 + x) * 16;
                LAS unsigned* slot = (LAS unsigned*)(lds + 139264);
                const attn_body::bf16* BQ = (const attn_body::bf16*)(ws + WS_BQ); const attn_body::bf16* BK = (const attn_body::bf16*)(ws + WS_BK); const attn_body::bf16* BV = (const attn_body::bf16*)(ws + WS_BV);
                const attn_body::bf16* CQ = (const attn_body::bf16*)(ws + WS_CQ); const attn_body::bf16* CK = (const attn_body::bf16*)(ws + WS_CK); const attn_body::bf16* CV = (const attn_body::bf16*)(ws + WS_CV);
                if (MK_TID() == 0) slot[0] = atomicAdd(qc, 1u);
                __syncthreads();
                int cur = __builtin_amdgcn_readfirstlane((int)slot[0]);
#pragma unroll 1
                while (cur < total) {
                    unsigned nxt = 0u;
                    const bool pre = cur >= 64;
                    if (pre && MK_TID() == 0) nxt = atomicAdd(qc, 1u);
                    if (cur < 64) {
                        const int qb = 31 - (cur >> 1), bh = 2 * x + (cur & 1), h = bh & 7, b = bh >> 3;
                        LAS float* kml = (LAS float*)(lds + 98304);
                        { const int t_ = MK_TID(); *(LAS f32x4*)(kml + 4 * t_) = *(const f32x4*)((const float*)(ws + WS_KMEAN) + (size_t)bh * 2048 + 4 * t_); asm volatile("s_waitcnt vmcnt(0) lgkmcnt(0)" ::: "memory"); __builtin_amdgcn_s_barrier(); }
                        attn_body::attn_unit<8, 0, 512, 512>(b, qb, h * 64, h * 64, CQ, CK, CV, (attn_body::bf16*)(ws + WS_CQ), (const LAS float*)kml, 0.f, (char*)lds_raw, MK_TID());
                    } else if (cur < 64 + ngx) {
                        const int gt = ngs + x + 8 * (cur - 64);
                        pg8::Gemm g{(const bf16_t*)(ws + WS_XG), (const bf16_t*)(ws + WS_W + WO_GATE), M, 3072, DMODEL}; OneTile S{gt & 63, gt >> 6};
                        fill_rstd_table(S, (const float*)(ws + WS_SSQ), lds, MK_TID());
                        EpiActMK<0> E{(const LAS float*)(lds + RSTD_TAB_OFF), (void*)(ws + WS_GS), 3072};
                        pg8::gemm_phase<EpiActMK<0>, OneTile, true, true>(lds, g, S, E, MK_TID());
                    } else if (cur >= 64 + ngx + 64) {
                        const int it_b = WQ_FIRST + WQ_CH * (x + 8 * (cur - 64 - ngx - 64));
                        const float* w_in = ka->in[2] + (size_t)l * DMODEL * NIN; const float* w_br = ka->in[4] + (size_t)l * 3 * 512 * 1024; const float* w_out = ka->in[5] + (size_t)l * 1024 * 1024;
                        const float* w_ff1 = ka->in[7] + (size_t)l * DMODEL * DFF; const float* w_ff2 = ka->in[8] + (size_t)l * DFF * DMODEL;
                        LAS float* scr = (LAS float*)(lds + wave * 16384);
                        int ln_ = mk_lane_id(); asm volatile("" : "+v"(ln_));
#pragma unroll 1
                        for (int it0 = it_b + wave; it0 < it_b + WQ_CH; it0 += 8) {
                            float va[32];
                            const TrItem t = tr_decode(it0, ln_, w_in, w_br, w_out, w_ff1, w_ff2, ws);
                            tr_load(t, va, ln_); tr_store(t, va, scr, ln_);
                        }
                    } else {
                        const int i = 64 * x + (cur - 64 - ngx);
                        const int qb = i & 31, bh = i >> 5, h = bh & 7, b = bh >> 3;
                        const float* sinks = ka->in[3] + l * 8;
                        attn_body::attn_unit<8, 1, 512, 128>(b, qb, h * 64, (h >> 2) * 64, BQ, BK, BV, (attn_body::bf16*)(ws + WS_BQ), (const LAS float*)nullptr, sinks[h] * LOG2E, (char*)lds_raw, MK_TID());
                    }
                    __syncthreads();
                    if (MK_TID() == 0) { if (!pre) nxt = atomicAdd(qc, 1u); slot[0] = nxt; }
                    __syncthreads();
                    cur = __builtin_amdgcn_readfirstlane((int)slot[0]);
                }
            }
#if defined(MK_ARRIVE_PROBE)
            if (MK_TID() == 0 && l == MK_ARRIVE_L) ((unsigned long long*)(ws + WS_CTL + 24576 + 64))[blockIdx.x] = __builtin_amdgcn_s_memrealtime();
#endif
            GRID_SYNC_I(3);
#if defined(MK_ARRIVE_PROBE)
            if (blockIdx.x == 0 && MK_TID() == 0 && l == MK_ARRIVE_L) {
                const unsigned long long* arr = (const unsigned long long*)(ws + WS_CTL + 24576 + 64);
                unsigned long long mx = 0ull, mn = ~0ull; int am = 0;
                for (int i = 0; i < (int)gridDim.x; ++i) { const unsigned long long t = __hip_atomic_load(arr + i, __ATOMIC_RELAXED, __HIP_MEMORY_SCOPE_AGENT); if (t > mx) { mx = t; am = i; } if (t < mn) mn = t; }
                int cnt = 0;
                for (int i = 0; i < (int)gridDim.x; ++i) { const unsigned long long t = __hip_atomic_load(arr + i, __ATOMIC_RELAXED, __HIP_MEMORY_SCOPE_AGENT); if (t + MK_ARRIVE_WIN >= mx) ++cnt; }
                const unsigned long long R = (MK_ARRIVE_PROBE == 1) ? (unsigned long long)am * 400ull : (MK_ARRIVE_PROBE == 2) ? (unsigned long long)cnt * 400ull : (mx - mn);
                __hip_atomic_store((unsigned long long*)(ws + WS_CTL + 24576), R, __ATOMIC_RELAXED, __HIP_MEMORY_SCOPE_AGENT);
            }
#endif
        }
#if !MK_POOL_GATE
        for (int rep_ = 0; rep_ < ((MK_DBL & PH_GATE) ? 2 : 1); ++rep_)
        if ((MK_EN & PH_GATE) && (pmask & PH_GATE)) {
            KARGS(ka); unsigned char* ws = ka->ws;
            pg8::Gemm g{(const bf16_t*)(ws + WS_XG), (const bf16_t*)(ws + WS_W + WO_GATE), M, 3072, DMODEL}; pg8::StaticOrder S; S.init(M, 3072, (int)gridDim.x, (int)blockIdx.x);
            fill_rstd_table(S, (const float*)(ws + WS_SSQ), lds, MK_TID());
            EpiActMK<0> E{(const LAS float*)(lds + RSTD_TAB_OFF), (void*)(ws + WS_GS), 3072};
            pg8::gemm_phase<EpiActMK<0>, pg8::StaticOrder, true, true>(lds, g, S, E, MK_TID());
            GRID_SYNC_I(4);
        }
#endif
        for (int rep_ = 0; rep_ < ((MK_DBL & PH_BRANCH) ? 2 : 1); ++rep_)
        if ((MK_EN & PH_BRANCH) && (pmask & PH_BRANCH)) {
            {
                KARGS(ka); unsigned char* ws = ka->ws;
                static_assert(WS_BQ - WS_AQ == (size_t)M * 512 * 2 && WS_CQ - WS_BQ == (size_t)M * 512 * 2, "O_a | O_b | O_c contiguous");
                {
                    const unsigned* bar = (const unsigned*)(ws + WS_CTL); bool ok = MK_GROUPS && (int)gridDim.x == 256;
#pragma unroll 1
                    for (int jx = 0; jx < 16; ++jx) { const unsigned c = xb_ld((unsigned*)bar + XB_XCNT(jx)); ok = ok && (jx < 8 ? c == 32u : c == 0u); }
                    const unsigned rk = xb_ld((unsigned*)(ws + WS_CTL + 19456) + blockIdx.x), xc = xb_xcc_id();
                    if (MK_TID() == 0) { LAS int* gl = (LAS int*)(lds + GRP_LDS); gl[0] = ok ? 1 : 0; gl[1] = (int)(xc + 8u * (rk >> 2)); gl[2] = (int)(rk & 3u); gl[3] = 2 * (l - l_lo); }
                    __syncthreads();
                }
                MK_GRP_LOAD();
                pg8::Gemm g{(const bf16_t*)(ws + WS_AQ), (const bf16_t*)(ws + WS_W + WO_BR), 3 * M, 3 * 1024, 512};
                BranchOrder S; S.S.init(M, 1024, (int)gridDim.x, (int)blockIdx.x); S.gm = gm_; S.gpm = gpm_; S.gj = gj_;
                EpiBranchMK E{(const unsigned char*)(ws + WS_GS), (bf16_t*)(ws + WS_MG)};
                pg8::gemm_phase<EpiBranchMK, BranchOrder, true, true>(lds, g, S, E, MK_TID());
            }
            { MK_GRP_LOAD(); MK_GRP_SYNC(5); }
        }
        if ((MK_EN & PH_OUT) && (pmask & PH_OUT)) {
            KARGS(ka); unsigned char* ws = ka->ws;
            MK_GRP_LOAD();
            pg8::Gemm g{(const bf16_t*)(ws + WS_MG), (const bf16_t*)(ws + WS_W + WO_OUT), M, 1024, 1024}; GSched S; S.S.init(M, 1024, (int)gridDim.x, (int)blockIdx.x); S.gm = gm_; S.pm = gpm_; S.pn0 = gj_; S.n = 1;
            EpiResMK E{(l == 0) ? ka->in[0] : (const float*)ka->out, ka->out, ka->in[6] + (size_t)l * DMODEL, (bf16_t*)(ws + WS_XG), (float*)(ws + WS_SSQ)};
            pg8::gemm_phase<EpiResMK, GSched, true, true>(lds, g, S, E, MK_TID());
            GRID_SYNC_I(6);
        }
        for (int rep_ = 0; rep_ < ((MK_DBL & PH_FF1) ? 2 : 1); ++rep_)
        if ((MK_EN & PH_FF1) && (pmask & PH_FF1)) {
            KARGS(ka); unsigned char* ws = ka->ws;
            MK_GRP_LOAD();
            pg8::Gemm g{(const bf16_t*)(ws + WS_XG), (const bf16_t*)(ws + WS_W + WO_FF1), M, DFF, DMODEL}; GSched S; S.S.init(M, DFF, (int)gridDim.x, (int)blockIdx.x); S.gm = gm_; S.pm = gpm_; S.pn0 = 4 * gj_; S.n = 4;
            fill_rstd_table(S, (const float*)(ws + WS_SSQ), lds, MK_TID());
            EpiActMK<1> E{(const LAS float*)(lds + RSTD_TAB_OFF), (bf16_t*)(ws + WS_U), DFF};
            pg8::gemm_phase<EpiActMK<1>, GSched, true, true>(lds, g, S, E, MK_TID(), (unsigned long long*)(ws + WS_CTL + 24576));
            MK_GRP_SYNC(7);
        }
        if ((MK_EN & PH_FF2) && (pmask & PH_FF2)) {
            KARGS(ka); unsigned char* ws = ka->ws;
            MK_GRP_LOAD();
            pg8::Gemm g{(const bf16_t*)(ws + WS_U), (const bf16_t*)(ws + WS_W + WO_FF2), M, 1024, DFF}; GSched S; S.S.init(M, 1024, (int)gridDim.x, (int)blockIdx.x); S.gm = gm_; S.pm = gpm_; S.pn0 = gj_; S.n = 1;
            if (ka->fin && l + 1 == l_hi && (int)gridDim.x == (M / 256) * (DMODEL / 256)) {
                const int n_ = __builtin_amdgcn_readfirstlane(((LAS int*)(lds + GRP_LDS))[3]) + 1;
                EpiResFinalMK E{(const float*)ka->out, ka->out, ka->in[9], (float*)(ws + WS_SSQ), (unsigned*)(ws + WS_CTL), gm_ ? (unsigned*)(ws + WS_CTL + CTL_GRP) + 16 * gpm_ : nullptr, 4u * (unsigned)n_};
                pg8::gemm_phase<EpiResFinalMK, GSched, true, true>(lds, g, S, E, MK_TID());
                fin_done = true;
            } else {
            EpiResMK E{(const float*)ka->out, ka->out, (l + 1 < 2) ? ka->in[1] + (size_t)(l + 1) * DMODEL : nullptr, (bf16_t*)(ws + WS_XG), (float*)(ws + WS_SSQ)};
            pg8::gemm_phase<EpiResMK, GSched, true, true>(lds, g, S, E, MK_TID());
            if (!(MK_WQ && l + 1 < l_hi && (pmask & PH_PREP))) GRID_SYNC_I(8);
            }
        }
    }
#if defined(PG8_STAMP) || defined(MK_STAMP_SYNC) || defined(DSA_STAMP) || defined(MK_ARRIVE_PROBE)
    { KARGS(kp); if (blockIdx.x == 0 && MK_TID() == 0) { unsigned long long acc_ = __hip_atomic_load((unsigned long long*)(kp->ws + WS_CTL + 24576), __ATOMIC_RELAXED, __HIP_MEMORY_SCOPE_AGENT);
 const unsigned long long t0_ = __builtin_amdgcn_s_memrealtime(); while (__builtin_amdgcn_s_memrealtime() - t0_ < acc_ * PG8_AMP) __builtin_amdgcn_s_sleep(8); } }
#endif
    {
        KARGS(ka);
        if (ka->fin && !fin_done) {
            PHASE_IDS();
            const int gw = blockIdx.x * 8 + wave, NGW = gridDim.x * 8;
            float* out = ka->out; const float* SSQ = (const float*)(ka->ws + WS_SSQ);
            const float4* gr = (const float4*)ka->in[9];
            float4 gg[4];
#pragma unroll
            for (int j = 0; j < 4; ++j) gg[j] = gr[lane + 64 * j];
            for (int m0 = gw; m0 < M; m0 += 2 * NGW) {
                float4 v[2][4]; float r2[2];
#pragma unroll
                for (int r = 0; r < 2; ++r) { const int m = (m0 + r * NGW < M) ? m0 + r * NGW : m0; const float4* xr = (const float4*)(out + (size_t)m * DMODEL); r2[r] = rstd_of(SSQ, m);
#pragma unroll
                    for (int j = 0; j < 4; ++j) v[r][j] = xr[lane + 64 * j]; }
#pragma unroll
                for (int r = 0; r < 2; ++r) { const int m = m0 + r * NGW; if (m < M) { float4* xr = (float4*)(out + (size_t)m * DMODEL);
#pragma unroll
                    for (int j = 0; j < 4; ++j) { float4 w = v[r][j]; const float q = r2[r]; w.x *= q * gg[j].x; w.y *= q * gg[j].y; w.z *= q * gg[j].z; w.w *= q * gg[j].w; xr[lane + 64 * j] = w; } } }
            }
        }
    }
}

extern "C" void kernel_launch(void* const* d_in, const int* in_sizes, int n_in, void* d_out, int out_size, void* d_ws, size_t ws_size, hipStream_t stream) {
    const float* x = (const float*)d_in[0];
    const float* norm1 = (const float*)d_in[1];
    const float* w_in = (const float*)d_in[2];
    const float* sinks = (const float*)d_in[3];
    const float* w_branch = (const float*)d_in[4];
    const float* w_out = (const float*)d_in[5];
    const float* norm2 = (const float*)d_in[6];
    const float* w_ff1 = (const float*)d_in[7];
    const float* w_ff2 = (const float*)d_in[8];
    const float* norm_f = (const float*)d_in[9];
    float* out = (float*)d_out;
    unsigned char* ws = (unsigned char*)d_ws;
    float* SSQ = (float*)(ws + WS_SSQ); float* IW = (float*)(ws + WS_IW); float* KMEAN = (float*)(ws + WS_KMEAN);
    float* COS = (float*)(ws + WS_COS); float* SIN = (float*)(ws + WS_SIN);
    bf16_t* XG = (bf16_t*)(ws + WS_XG);
    bf16_t *AQ = (bf16_t*)(ws + WS_AQ), *BQ = (bf16_t*)(ws + WS_BQ), *CQ = (bf16_t*)(ws + WS_CQ);
    bf16_t *AK = (bf16_t*)(ws + WS_AK), *AV = (bf16_t*)(ws + WS_AV), *IQ = (bf16_t*)(ws + WS_IQ), *IK = (bf16_t*)(ws + WS_IK);
    bf16_t *BK = (bf16_t*)(ws + WS_BK), *BV = (bf16_t*)(ws + WS_BV), *CK = (bf16_t*)(ws + WS_CK), *CV = (bf16_t*)(ws + WS_CV);
    bf16_t *GS = (bf16_t*)(ws + WS_GS), *MG = (bf16_t*)(ws + WS_MG), *U = (bf16_t*)(ws + WS_U);
    unsigned short* SEL = (unsigned short*)(ws + WS_SEL);
    (void)w_in; (void)w_branch; (void)w_out; (void)w_ff1; (void)w_ff2; (void)norm1; (void)norm2; (void)norm_f; (void)x; (void)XG; (void)SSQ; (void)GS; (void)MG; (void)U; (void)COS; (void)SIN; (void)IW;

    static int grid = 0;
    if (grid == 0) {
        int dev = 0, cus = 0, per_cu = 0;
        hipGetDevice(&dev);
        hipDeviceGetAttribute(&cus, hipDeviceAttributeMultiprocessorCount, dev);
        hipFuncSetAttribute((const void*)mk_fwd, hipFuncAttributeMaxDynamicSharedMemorySize, MK_LDS);
        hipOccupancyMaxActiveBlocksPerMultiprocessor(&per_cu, (const void*)mk_fwd, 512, MK_LDS);
        if (per_cu < 1) per_cu = 1;
        grid = cus;
        (void)hipGetLastError();
    }
    auto launch_mk = [&](int l_lo, int l_hi, int pmask, int fin) {
        MKArgs a{};
        for (int i = 0; i < 10; ++i) a.in[i] = (const float*)d_in[i];
        a.out = out; a.ws = ws; a.l_lo = l_lo; a.l_hi = l_hi; a.pmask = pmask; a.fin = fin;
        void* args[] = {&a};
        hipMemsetAsync(ws + WS_CTL, 0, CTL_ZERO_BYTES, stream);
        hipLaunchCooperativeKernel((const void*)mk_fwd, dim3(grid), dim3(512), args, MK_LDS, stream);
    };
    launch_mk(0, 2, 0x1ff, 1);
}
```

```cpp
#include <hip/hip_runtime.h>
#include <stdint.h>

typedef unsigned short bf16_t;
#define DEVI __device__ __forceinline__

constexpr int BATCH = 2, SEQ = 8192, DMODEL = 1024, M = BATCH * SEQ, NIN = 6340, DFF = 4096;
constexpr int NPROJ = 3268;
constexpr float EPS = 1e-6f;
constexpr float C2 = 0.125f * 1.4426950408889634f;
constexpr float LOG2E = 1.4426950408889634f;

constexpr size_t MiB = 1u << 20;
constexpr size_t WS_CTL = 0;
constexpr size_t WS_SSQ = 1 * MiB;
constexpr size_t WS_IW = 2 * MiB;
constexpr size_t WS_KMEAN = 2 * MiB + 512 * 1024;
constexpr size_t WS_COS = 3 * MiB, WS_SIN = 4 * MiB;
constexpr size_t WS_W = 6 * MiB;
constexpr size_t WS_XG = 40 * MiB;
constexpr size_t WS_AQ = 72 * MiB, WS_BQ = 88 * MiB, WS_CQ = 104 * MiB;
constexpr size_t WS_AK = 120 * MiB, WS_AV = 122 * MiB, WS_IQ = 124 * MiB, WS_IK = 132 * MiB;
constexpr size_t WS_BK = 134 * MiB, WS_BV = 138 * MiB, WS_CK = 142 * MiB, WS_CV = 158 * MiB;
constexpr size_t WS_GS = 174 * MiB;
constexpr size_t WS_MG = 222 * MiB;
constexpr size_t WS_U = 120 * MiB;
constexpr size_t WS_SEL = 248 * MiB;

DEVI float bf2f(bf16_t v) { return __uint_as_float((unsigned)v << 16); }
DEVI bf16_t f2bf(float f) { unsigned u = __float_as_uint(f); return (bf16_t)((u + 0x7fffu + ((u >> 16) & 1u)) >> 16); }
DEVI float wave_sum(float v) {
#pragma unroll
    for (int o = 1; o < 64; o <<= 1) v += __shfl_xor(v, o);
    return v;
}
DEVI float wave_max(float v) {
#pragma unroll
    for (int o = 1; o < 64; o <<= 1) v = fmaxf(v, __shfl_xor(v, o));
    return v;
}
DEVI float rstd_of(const float* ssq, int m) {
    const float4* p = (const float4*)(ssq + (size_t)m * 16);
    float4 a = p[0], b = p[1], c = p[2], d = p[3];
    float s = ((a.x + a.y) + (a.z + a.w)) + ((b.x + b.y) + (b.z + b.w)) + ((c.x + c.y) + (c.z + c.w)) + ((d.x + d.y) + (d.z + d.w));
    return rsqrtf(s * (1.0f / DMODEL) + EPS);
}

__device__ const double INVF[32] = {
    1.00000000000000000e+00, 7.49894209332455874e-01, 5.62341325190349073e-01, 4.21696503428582226e-01,
    3.16227766016837941e-01, 2.37137370566165517e-01, 1.77827941003892293e-01, 1.33352143216332403e-01,
    1.00000000000000006e-01, 7.49894209332455791e-02, 5.62341325190349114e-02, 4.21696503428582239e-02,
    3.16227766016837913e-02, 2.37137370566165538e-02, 1.77827941003892293e-02, 1.33352143216332406e-02,
    1.00000000000000002e-02, 7.49894209332455791e-03, 5.62341325190349097e-03, 4.21696503428582292e-03,
    3.16227766016837939e-03, 2.37137370566165538e-03, 1.77827941003892275e-03, 1.33352143216332406e-03,
    1.00000000000000002e-03, 7.49894209332455856e-04, 5.62341325190349097e-04, 4.21696503428582237e-04,
    3.16227766016837939e-04, 2.37137370566165538e-04, 1.77827941003892270e-04, 1.33352143216332395e-04};

DEVI void sincos_tab(int idx, float* cs, float* sn) {
    const int pos = idx >> 5, f = idx & 31;
    double a = (double)pos * INVF[f];
    const double TWO_PI = 6.283185307179586476925286766559;
    double k = rint(a / TWO_PI);
    double r = a - k * TWO_PI;
    double r2 = r * r;
    double s = 0.0, c = 0.0, ts = r, tc = 1.0;
#pragma unroll 1
    for (int n = 0; n < 16; ++n) {
        c += tc; s += ts;
        tc = -tc * r2 / (double)((2 * n + 1) * (2 * n + 2));
        ts = -ts * r2 / (double)((2 * n + 2) * (2 * n + 3));
    }
    cs[idx] = (float)c; sn[idx] = (float)s;
}

#if defined(PG8_STAMP)
#if PG8_USE_SHADERCLK
#define PG8_CLK() ((unsigned long long)__builtin_readcyclecounter())
#else
#define PG8_CLK() ((unsigned long long)__builtin_amdgcn_s_memrealtime())
#endif
#endif
namespace pg8 {
#define PG8_LAS __attribute__((address_space(3)))
typedef unsigned short bf16_t;
typedef short bf16x8 __attribute__((ext_vector_type(8)));
typedef float f32x4 __attribute__((ext_vector_type(4)));
typedef unsigned u32x4 __attribute__((ext_vector_type(4)));
constexpr int BM = 256, BK = 64, HALF = 128, HTB = HALF * BK * 2  , STAGE_BYTES = 8 * HTB, NXCD = 8, WGM = 8;

__host__ __device__ __forceinline__ int lds_byte(int r, int c) { const int st = (r >> 4) * 2 + (c >> 5), rr = r & 15, cc = c & 31, ob = rr * 64 + cc * 2; return st * 1024 + (ob ^ (((ob >> 9) & 1) << 5)); }
__host__ __device__ __forceinline__ void stage_rc(int b, int& R, int& C) { const int st = b / 1024, sb = b % 1024, swz = sb ^ (((sb >> 9) & 1) << 5); R = (st >> 1) * 16 + swz / 64; C = (st & 1) * 32 + (swz % 64) / 2; }
__host__ __device__ __forceinline__ int perm32(int rho) { const int n = rho >> 4, i = rho & 15; return 8 * (i >> 2) + 4 * n + (i & 3); }

struct Unit { int pm, pn, ord; };
struct Gemm { const bf16_t* A; const bf16_t* Bt; int M, N, K; };

struct StaticOrder {
    int nM, nN, nwg, G, c;
    __host__ __device__ void init(int M, int N, int G_, int c_) { nM = M / BM; nN = N / BM; nwg = nM * nN; G = G_; c = c_; }
    __host__ __device__ bool next(int i, Unit& u) const {
        const long L = (long)i * G + c; if (L >= nwg) return false;
        int wgid = (int)L; { const int q = nwg / NXCD, r = nwg % NXCD, xcd = wgid % NXCD, off = wgid / NXCD; wgid = (xcd < r ? xcd * (q + 1) : r * (q + 1) + (xcd - r) * q) + off; }
        const int nig = WGM * nN, gid = wgid / nig, fm = gid * WGM, gsz = (nM - fm) < WGM ? (nM - fm) : WGM;
        u.pm = fm + ((wgid % nig) % gsz); u.pn = (wgid % nig) / gsz; u.ord = i; return true;
    }
    __device__ __forceinline__ void a_ready(const Unit&) const {}
    __device__ __forceinline__ void done(const Unit&) const {}
};

__device__ __forceinline__ unsigned cvt_pk_bf16(float lo, float hi) { unsigned r; asm volatile("v_cvt_pk_bf16_f32 %0, %1, %2" : "=v"(r) : "v"(lo), "v"(hi)); return r; }
typedef float f32x2 __attribute__((ext_vector_type(2)));
template <class Epi, class Sched, bool ALIGN_EPI = false, bool SP2 = false>
__device__ __forceinline__ void gemm_phase(PG8_LAS unsigned char* lds, const Gemm g, const Sched& S, const Epi& E, int tid_in, unsigned long long* g_probe_acc = nullptr) {
    int tid_l = tid_in; asm volatile("" : "+v"(tid_l));
    const int tid = tid_l, wid = __builtin_amdgcn_readfirstlane(tid >> 6), lane = tid & 63, wr = wid >> 2, wc = wid & 3, fr = lane & 15, fq = lane >> 4;
    const int K = g.K, nt = K / BK;
    unsigned voffA[2], voffB[2];
#pragma unroll
    for (int i = 0; i < 2; ++i) { int R, C; stage_rc(tid * 16 + i * 8192, R, C); const int Rb = Epi::PERM ? ((R & ~31) + perm32(R & 31)) : R;
        voffA[i] = (unsigned)(R * K + C) * 2u; voffB[i] = (unsigned)(Rb * K + C) * 2u; }
    const size_t kstep = (size_t)(BK * 2);
    const size_t hstep = (size_t)HALF * K * 2;
    const size_t tstep = 2 * hstep;
    const unsigned ldsw = (unsigned)wid * 1024u;
    const int aoff = lds_byte(wr * 64 + fr, fq * 8), boff = lds_byte(wc * 32 + fr, fq * 8);
#define PG8_SA(b, h) (((b) * 2 + (h)) * HTB)
#define PG8_SB(b, h) ((4 + (b) * 2 + (h)) * HTB)
#define PG8_STAGE(bufoff, gbase, voff) do { _Pragma("unroll") for (int _i = 0; _i < 2; ++_i) \
        __builtin_amdgcn_global_load_lds((const unsigned*)((const char*)(gbase) + (voff)[_i]), (PG8_LAS unsigned*)(lds + (bufoff) + ldsw + _i * 8192), 16, 0, 0); } while (0)
#define PG8_LDA(dst, b, h) do { _Pragma("unroll") for (int m = 0; m < 4; ++m) _Pragma("unroll") for (int k = 0; k < 2; ++k) dst[m][k] = *(const PG8_LAS bf16x8*)(lds + PG8_SA(b, h) + aoff + m * 2048 + k * 1024); } while (0)
#define PG8_LDB(dst, b, h) do { _Pragma("unroll") for (int n = 0; n < 2; ++n) _Pragma("unroll") for (int k = 0; k < 2; ++k) dst[n][k] = *(const PG8_LAS bf16x8*)(lds + PG8_SB(b, h) + boff + n * 2048 + k * 1024); } while (0)
#define PG8_MMA(ai, bj, At, Bt) do { __builtin_amdgcn_s_setprio(1); _Pragma("unroll") for (int m = 0; m < 4; ++m) _Pragma("unroll") for (int n = 0; n < 2; ++n) _Pragma("unroll") for (int k = 0; k < 2; ++k) \
        acc[ai][bj][m][n] = __builtin_amdgcn_mfma_f32_16x16x32_bf16(Bt[n][k], At[m][k], acc[ai][bj][m][n], 0, 0, 0); __builtin_amdgcn_s_setprio(0); } while (0)
#define PG8_WAIT_V(n) asm volatile("s_waitcnt vmcnt(" #n ")" ::: "memory")
#define PG8_WAIT_L(n) asm volatile("s_waitcnt lgkmcnt(" #n ")" ::: "memory")
#define PG8_BAR __builtin_amdgcn_s_barrier()
#define PG8_SCHED __builtin_amdgcn_sched_barrier(0)
    Unit cur, nxt; int ui = 0;
    if (!S.next(0, cur)) return;
    f32x4 acc[2][2][4][2];
#pragma unroll
    for (int a = 0; a < 2; ++a)
#pragma unroll
        for (int b = 0; b < 2; ++b)
#pragma unroll
            for (int m = 0; m < 4; ++m)
#pragma unroll
                for (int n = 0; n < 2; ++n) acc[a][b][m][n] = (f32x4){0.f, 0.f, 0.f, 0.f};
    bf16x8 At[4][2], B0[2][2], B1[2][2];
    const char* cA = (const char*)g.A + (size_t)cur.pm * tstep; const char* cB = (const char*)g.Bt + (size_t)cur.pn * tstep;
    S.a_ready(cur);
    if constexpr (SP2) {
        PG8_STAGE(PG8_SB(0, 0), cB, voffB); PG8_STAGE(PG8_SB(0, 1), cB + hstep, voffB); PG8_STAGE(PG8_SA(0, 0), cA, voffA); PG8_STAGE(PG8_SA(0, 1), cA + hstep, voffA);
        if (wr == 1) PG8_BAR;
        PG8_WAIT_V(2); PG8_BAR;
        PG8_STAGE(PG8_SB(1, 0), cB + kstep, voffB); PG8_STAGE(PG8_SA(1, 0), cA + kstep, voffA); PG8_STAGE(PG8_SB(1, 1), cB + hstep + kstep, voffB);
        PG8_WAIT_V(6); PG8_BAR;
    } else {
        PG8_STAGE(PG8_SB(0, 0), cB, voffB); PG8_STAGE(PG8_SA(0, 0), cA, voffA); PG8_STAGE(PG8_SB(0, 1), cB + hstep, voffB); PG8_STAGE(PG8_SA(0, 1), cA + hstep, voffA);
        if (wr == 1) PG8_BAR;
        PG8_WAIT_V(4); PG8_BAR;
        PG8_STAGE(PG8_SB(1, 0), cB + kstep, voffB); PG8_STAGE(PG8_SA(1, 0), cA + kstep, voffA); PG8_STAGE(PG8_SB(1, 1), cB + hstep + kstep, voffB);
        PG8_WAIT_V(6); PG8_BAR;
    }
    for (;;) {
        const bool has_next = S.next(ui + 1, nxt);
        const char* nA = has_next ? (const char*)g.A + (size_t)nxt.pm * tstep : cA; const char* nB = has_next ? (const char*)g.Bt + (size_t)nxt.pn * tstep : cB;
#if defined(PG8_STAMP)
        unsigned long long st0_ = 0; if constexpr (Epi::PROBE_DBL) { if (blockIdx.x == PG8_STAMP_BLK && wid == PG8_STAMP_WAVE) st0_ = PG8_CLK(); }
#endif
        for (int t = 0; t < nt; t += 2) {
            const bool last = (t == nt - 2);
            const char* a1 = cA + (size_t)(t + 1) * kstep;
            const char* a2 = last ? nA : cA + (size_t)(t + 2) * kstep; const char* b2 = last ? nB : cB + (size_t)(t + 2) * kstep;
            const char* a3 = a2 + kstep; const char* b3 = b2 + kstep;
            if (last && has_next) S.a_ready(nxt);
            if constexpr (SP2) {
            PG8_LDB(B0, 0, 0); PG8_LDB(B1, 0, 1); PG8_SCHED; PG8_LDA(At, 0, 0); PG8_STAGE(PG8_SA(1, 1), a1 + hstep, voffA);
            PG8_WAIT_V(8); PG8_WAIT_L(0); PG8_BAR; PG8_MMA(0, 0, At, B0); PG8_MMA(0, 1, At, B1); PG8_BAR; PG8_SCHED;
            PG8_LDA(At, 0, 1); PG8_STAGE(PG8_SB(0, 0), b2, voffB); PG8_STAGE(PG8_SB(0, 1), b2 + hstep, voffB); PG8_STAGE(PG8_SA(0, 0), a2, voffA);
            PG8_WAIT_V(8); PG8_WAIT_L(0); PG8_BAR; PG8_MMA(1, 0, At, B0); PG8_MMA(1, 1, At, B1); PG8_BAR; PG8_SCHED;
            PG8_LDB(B0, 1, 0); PG8_LDB(B1, 1, 1); PG8_SCHED; PG8_LDA(At, 1, 0); PG8_STAGE(PG8_SA(0, 1), a2 + hstep, voffA);
            PG8_WAIT_V(8); PG8_WAIT_L(0); PG8_BAR; PG8_MMA(0, 0, At, B0); PG8_MMA(0, 1, At, B1); PG8_BAR; PG8_SCHED;
            PG8_LDA(At, 1, 1); PG8_STAGE(PG8_SB(1, 0), b3, voffB); PG8_STAGE(PG8_SB(1, 1), b3 + hstep, voffB); PG8_STAGE(PG8_SA(1, 0), a3, voffA);
            PG8_WAIT_V(8); PG8_WAIT_L(0); PG8_BAR; PG8_MMA(1, 0, At, B0); PG8_MMA(1, 1, At, B1); PG8_BAR; PG8_SCHED;
            } else {
            PG8_LDB(B0, 0, 0); PG8_SCHED; PG8_LDA(At, 0, 0); PG8_STAGE(PG8_SA(1, 1), a1 + hstep, voffA);
            PG8_WAIT_L(8); PG8_BAR; PG8_WAIT_L(0); PG8_MMA(0, 0, At, B0); PG8_BAR; PG8_SCHED;
            PG8_LDB(B1, 0, 1); PG8_STAGE(PG8_SB(0, 0), b2, voffB);
            PG8_BAR; PG8_WAIT_L(0); PG8_MMA(0, 1, At, B1); PG8_BAR;
            PG8_LDA(At, 0, 1); PG8_STAGE(PG8_SA(0, 0), a2, voffA);
            PG8_BAR; PG8_WAIT_L(0); PG8_MMA(1, 0, At, B0); PG8_BAR; PG8_SCHED;
            PG8_STAGE(PG8_SB(0, 1), b2 + hstep, voffB);
            PG8_WAIT_V(6); PG8_BAR; PG8_MMA(1, 1, At, B1); PG8_BAR;
            PG8_LDB(B0, 1, 0); PG8_SCHED; PG8_LDA(At, 1, 0); PG8_STAGE(PG8_SA(0, 1), a2 + hstep, voffA);
            PG8_WAIT_L(8); PG8_BAR; PG8_WAIT_L(0); PG8_MMA(0, 0, At, B0); PG8_BAR; PG8_SCHED;
            PG8_LDB(B1, 1, 1); PG8_STAGE(PG8_SB(1, 0), b3, voffB);
            PG8_BAR; PG8_WAIT_L(0); PG8_MMA(0, 1, At, B1); PG8_BAR;
            PG8_LDA(At, 1, 1); PG8_STAGE(PG8_SA(1, 0), a3, voffA);
            PG8_BAR; PG8_WAIT_L(0); PG8_MMA(1, 0, At, B0); PG8_BAR; PG8_SCHED;
            PG8_STAGE(PG8_SB(1, 1), b3 + hstep, voffB);
            PG8_WAIT_V(6); PG8_BAR; PG8_MMA(1, 1, At, B1); PG8_BAR;
            }
        }
        if constexpr (ALIGN_EPI) { if (wr == 0) PG8_BAR; }
#if defined(PG8_STAMP)
        unsigned long long st1_ = 0; if constexpr (Epi::PROBE_DBL) { if (blockIdx.x == PG8_STAMP_BLK && wid == PG8_STAMP_WAVE) { st1_ = PG8_CLK(); if (PG8_STAMP == 1 && lane == 0) atomicAdd(g_probe_acc, (st1_ - st0_) >> PG8_SHIFT); } }
#endif
#if defined(PG8_DBL_EPI)
        if constexpr (Epi::PROBE_DBL) { E(acc, cur, wr, wc, fr, fq); asm volatile("" ::: "memory"); }
#endif
        if constexpr (!Epi::AFTER_DRAIN) { E(acc, cur, wr, wc, fr, fq); S.done(cur); }
#if defined(PG8_STAMP)
        if constexpr (Epi::PROBE_DBL) { if (blockIdx.x == PG8_STAMP_BLK && wid == PG8_STAMP_WAVE) { asm volatile("s_waitcnt vmcnt(0)" ::: "memory"); const unsigned long long st2_ = PG8_CLK(); if (PG8_STAMP == 2 && lane == 0) atomicAdd(g_probe_acc, (st2_ - st1_) >> PG8_SHIFT); } }
#endif
        if (!has_next) break;
#pragma unroll
        for (int a = 0; a < 2; ++a)
#pragma unroll
            for (int b = 0; b < 2; ++b)
#pragma unroll
                for (int m = 0; m < 4; ++m)
#pragma unroll
                    for (int n = 0; n < 2; ++n) acc[a][b][m][n] = (f32x4){0.f, 0.f, 0.f, 0.f};
        cur = nxt; cA = nA; cB = nB; ++ui;
        if constexpr (ALIGN_EPI) { if (wr == 1) PG8_BAR; }
    }
    PG8_WAIT_V(0);
    if constexpr (!ALIGN_EPI) { if (wr == 0) PG8_BAR; }
    PG8_BAR;
    if constexpr (Epi::AFTER_DRAIN) { E.fused(acc, cur, wr, wc, fr, fq, lds, wid, lane); S.done(cur); }
#undef PG8_SA
#undef PG8_SB
#undef PG8_STAGE
#undef PG8_LDA
#undef PG8_LDB
#undef PG8_MMA
#undef PG8_WAIT_V
#undef PG8_WAIT_L
#undef PG8_BAR
#undef PG8_SCHED
}
}

#include <hip/hip_bf16.h>
#include <cmath>
namespace attn_body {
using bf16=__hip_bfloat16;
using bf16x8=__attribute__((ext_vector_type(8)))short;
using s16x4=__attribute__((ext_vector_type(4)))short;
using f32x16=__attribute__((ext_vector_type(16)))float;
using u32x4=__attribute__((ext_vector_type(4)))unsigned;
typedef float f32x4 __attribute__((ext_vector_type(4)));
constexpr int SEQ=8192,D=64;
constexpr int NW=8,QBLK=32,QB=QBLK*NW,KVBLK=64,NQB=SEQ/QB;
__device__ __forceinline__ int crow(int r,int hi){return (r&3)+8*(r>>2)+4*hi;}
#define SBAR() __builtin_amdgcn_sched_barrier(0)
__device__ __forceinline__ void cmask(f32x16&p0,f32x16&p1,int jb,int qrel,int hi){
  const float NEG=-INFINITY; int kb=64*jb+4*hi;
  #pragma unroll
  for(int r=0;r<16;++r){int kv=kb+(r&3)+8*(r>>2); if(kv>qrel)p0[r]=NEG; if(kv+32>qrel)p1[r]=NEG;}
}

__device__ __forceinline__ void wmask(f32x16&p0,f32x16&p1,int k0,int qrel,int hi){
  const float NEG=-INFINITY; const int kb=k0+4*hi;
  #pragma unroll
  for(int r=0;r<16;++r){const int kv=kb+(r&3)+8*(r>>2); if((unsigned)(qrel-kv)>=128u)p0[r]=NEG; if((unsigned)(qrel-kv-32)>=128u)p1[r]=NEG;}
}
constexpr int NSLOT=3, SLOTB=8192;
constexpr int LDS_K=0, LDS_V=NSLOT*SLOTB, LDS_WS=2*NSLOT*SLOTB, LDS_OST=LDS_WS+NW*64*4, LDS_BYTES=LDS_OST+NW*4096;
constexpr float C2=0.125f*1.4426950408889634f;
__device__ __forceinline__ void glds16(const void*gsrc,unsigned lds_dst){unsigned keep;
  asm volatile("s_mov_b32 %0, m0\n\ts_mov_b32 m0, %2\n\ts_nop 0\n\tglobal_load_lds_dwordx4 %1, off\n\ts_mov_b32 m0, %0":"=&s"(keep):"v"(gsrc),"s"(lds_dst):"memory");}
__device__ __forceinline__ float max3f(float a,float b,float c){float r;asm("v_max3_f32 %0, %1, %2, %3":"=v"(r):"v"(a),"v"(b),"v"(c));return r;}
__device__ __forceinline__ float max2f(float a,float b){float r;asm("v_max_f32_e32 %0, %1, %2":"=v"(r):"v"(a),"v"(b));return r;}
__device__ __forceinline__ float fadd_s(float a,float b){float r;asm("v_add_f32_e32 %0, %1, %2":"=v"(r):"v"(a),"v"(b));return r;}
__device__ __forceinline__ float fsub_s(float a,float b){float r;asm("v_sub_f32_e32 %0, %1, %2":"=v"(r):"v"(a),"v"(b));return r;}
typedef float f32x2_t __attribute__((ext_vector_type(2))); typedef __bf16 bf16x2_t __attribute__((ext_vector_type(2)));
__device__ __forceinline__ unsigned cvtpk_s(float lo,float hi){f32x2_t v={lo,hi};bf16x2_t b=__builtin_convertvector(v,bf16x2_t);return __builtin_bit_cast(unsigned,b);}
#define WAIT_BAR(N) asm volatile("s_waitcnt vmcnt(" #N ") lgkmcnt(0)\n\ts_barrier":::"memory")

__device__ __forceinline__ void qkt(f32x16&p0,f32x16&p1,const char*Kslot,const bf16x8*qr,const f32x16&negm,int r32,int hi){
  const char*kb=Kslot+hi*1024+r32*16;
  #pragma unroll
  for(int d0=0;d0<4;++d0){
    const bf16x8 b0=*reinterpret_cast<const bf16x8*>(kb+d0*2048);
    const bf16x8 b1=*reinterpret_cast<const bf16x8*>(kb+d0*2048+512);
    if(d0==0){p0=__builtin_amdgcn_mfma_f32_32x32x16_bf16(b0,qr[0],negm,0,0,0);p1=__builtin_amdgcn_mfma_f32_32x32x16_bf16(b1,qr[0],negm,0,0,0);}
    else{p0=__builtin_amdgcn_mfma_f32_32x32x16_bf16(b0,qr[d0],p0,0,0,0);p1=__builtin_amdgcn_mfma_f32_32x32x16_bf16(b1,qr[d0],p1,0,0,0);}}
}
typedef __attribute__((address_space(3))) const char* lds_cptr;
typedef short v4i16_t __attribute__((ext_vector_type(4)));
__device__ __forceinline__ void kload8(bf16x8*kf,lds_cptr kp){
  kf[0]=*(const __attribute__((address_space(3))) bf16x8*)(kp);      kf[1]=*(const __attribute__((address_space(3))) bf16x8*)(kp+512);
  kf[2]=*(const __attribute__((address_space(3))) bf16x8*)(kp+2048); kf[3]=*(const __attribute__((address_space(3))) bf16x8*)(kp+2560);
  kf[4]=*(const __attribute__((address_space(3))) bf16x8*)(kp+4096); kf[5]=*(const __attribute__((address_space(3))) bf16x8*)(kp+4608);
  kf[6]=*(const __attribute__((address_space(3))) bf16x8*)(kp+6144); kf[7]=*(const __attribute__((address_space(3))) bf16x8*)(kp+6656);
}
__device__ __forceinline__ void kload2(bf16x8*kf,lds_cptr kp,int j){ kf[2*j]=*(const __attribute__((address_space(3))) bf16x8*)(kp+j*2048); kf[2*j+1]=*(const __attribute__((address_space(3))) bf16x8*)(kp+j*2048+512); }
__device__ __forceinline__ s16x4 vtr(lds_cptr p){ return __builtin_bit_cast(s16x4,__builtin_amdgcn_ds_read_tr16_b64_v4i16((__attribute__((address_space(3))) v4i16_t*)p)); }
__device__ __forceinline__ float rowmax(const f32x16&p0,const f32x16&p1){
  float a=max3f(p0[0],p0[1],p1[0]),b=max3f(p0[2],p0[3],p1[1]);a=max3f(a,p1[2],p1[3]);
  #pragma unroll
  for(int r=4;r<16;r+=4){a=max3f(a,p0[r],p0[r+1]);b=max3f(b,p0[r+2],p0[r+3]);a=max3f(a,p1[r],p1[r+1]);b=max3f(b,p1[r+2],p1[r+3]);}
  const float m=max2f(a,b);
  auto rr=__builtin_amdgcn_permlane32_swap(__float_as_uint(m),__float_as_uint(m),false,false);
  return max2f(__uint_as_float(rr[0]),__uint_as_float(rr[1]));
}
__device__ __forceinline__ void pv(f32x16*o,int vb,bf16x8 pa0,bf16x8 pa1,bf16x8 pa2,bf16x8 pa3){
  #pragma unroll
  for(int d0=0;d0<2;++d0){s16x4 lo[4],hi[4];
    #pragma unroll
    for(int ks=0;ks<4;++ks){
      asm volatile("ds_read_b64_tr_b16 %0,%1 offset:%c2":"=&v"(lo[ks]):"v"(vb),"i"(d0*4096+ks*1024):"memory");
      asm volatile("ds_read_b64_tr_b16 %0,%1 offset:%c2":"=&v"(hi[ks]):"v"(vb),"i"(d0*4096+ks*1024+512):"memory");}
    asm volatile("s_waitcnt lgkmcnt(0)":::"memory");SBAR();
    #define PK(k) (bf16x8){lo[k][0],lo[k][1],lo[k][2],lo[k][3],hi[k][0],hi[k][1],hi[k][2],hi[k][3]}
    o[d0]=__builtin_amdgcn_mfma_f32_32x32x16_bf16(pa0,PK(0),o[d0],0,0,0);
    o[d0]=__builtin_amdgcn_mfma_f32_32x32x16_bf16(pa1,PK(1),o[d0],0,0,0);
    o[d0]=__builtin_amdgcn_mfma_f32_32x32x16_bf16(pa2,PK(2),o[d0],0,0,0);
    o[d0]=__builtin_amdgcn_mfma_f32_32x32x16_bf16(pa3,PK(3),o[d0],0,0,0);
    #undef PK
  }
}

#ifndef ATTN_STORE16
#define ATTN_STORE16(p,v) (*(u32x4*)(p)=(v))
#endif
template<int THRL,int MODE,int QP,int KP> __device__ __forceinline__ void attn_unit(int b,int qb,int qcol,int kcol,const bf16*Q,const bf16*__restrict__ K,const bf16*__restrict__ V,bf16*O,const __attribute__((address_space(3))) float* kmean,float sink2,char*shm,int tid_in){
  int tid_l=tid_in; asm volatile("":"+v"(tid_l));
  const int tid=tid_l,lane=tid&63,r32=lane&31,hi=lane>>5; const int wid=__builtin_amdgcn_readfirstlane(tid>>6);
  const long rowbase=(long)b*SEQ; const int q0=qb*QB;
  const int T0=(MODE==1&&qb>0)?4*qb-2:0;
  const bf16*Qw=Q+(rowbase+q0+wid*QBLK)*QP+qcol;
  const bf16*Kh=K+(rowbase+T0*KVBLK)*KP+kcol,*Vh=V+(rowbase+T0*KVBLK)*KP+kcol;
  const unsigned lds0=(unsigned)(uintptr_t)shm;
  float*wsf=(float*)(shm+LDS_WS)+wid*64;
  const bf16*ksrc=Kh+(long)lane*KP+wid*8;
  const bf16*vsrc=Vh+(long)(16*(wid&3)+(lane>>2))*KP+(wid>>2)*32+(lane&3)*8;
  const unsigned kdst=lds0+LDS_K+wid*1024, vdst=lds0+LDS_V+wid*1024;
  #define DMA_K(t,slot) glds16(ksrc+(long)(t)*KVBLK*KP,(unsigned)__builtin_amdgcn_readfirstlane(kdst+(slot)))
  #define DMA_V(t,slot) glds16(vsrc+(long)(t)*KVBLK*KP,(unsigned)__builtin_amdgcn_readfirstlane(vdst+(slot)))
  const int vb0=(int)(lds0+LDS_V)+((lane>>4)&1)*32+(lane&3)*8+(4*hi+((lane&15)>>2))*64;
  const char*Kbase=shm+LDS_K; bf16x8 kf[8];
  const lds_cptr shm3=(lds_cptr)shm; const lds_cptr kp0=shm3+LDS_K+hi*1024+r32*16; const lds_cptr vp0=shm3+LDS_V+((lane>>4)&1)*32+(lane&3)*8+(4*hi+((lane&15)>>2))*64;
  const int NT=(MODE==1)?((qb>0)?6:4):(q0+QB)/KVBLK;
  DMA_K(0,0);DMA_V(0,0);DMA_K(1,SLOTB);
  bf16x8 qr[4];
  #pragma unroll
  for(int d0=0;d0<4;++d0)qr[d0]=*reinterpret_cast<const bf16x8*>(&Qw[(long)r32*QP+d0*16+hi*8]);
  float zl_=0.f; asm volatile("":"+v"(zl_));
  float mhat=0.f,l_reg=0.f;f32x16 o[2],negm;
  #pragma unroll
  for(int r_=0;r_<16;++r_){o[0][r_]=zl_;o[1][r_]=zl_;negm[r_]=zl_;}
  asm volatile("":"+v"(negm));
  const int qrel=wid*QBLK+r32;
  unsigned selmask=0u;
  if(MODE==0){ float v1=-INFINITY,v2=-INFINITY,v3=-INFINITY; int i1=-1,i2=-1,i3=-1;
    for(int j=0;j<qb;++j){ const __attribute__((address_space(3))) float*km=kmean+j*64+hi*8; float g=0.f;
      #pragma unroll
      for(int d0=0;d0<4;++d0){ const f32x4 ka=*(const __attribute__((address_space(3))) f32x4*)(km+d0*16), kb=*(const __attribute__((address_space(3))) f32x4*)(km+d0*16+4);
        #pragma unroll
        for(int e=0;e<4;++e){ g=__builtin_fmaf(__uint_as_float(((unsigned)(unsigned short)qr[d0][e])<<16),ka[e],g); g=__builtin_fmaf(__uint_as_float(((unsigned)(unsigned short)qr[d0][4+e])<<16),kb[e],g);} }
      { auto rr_=__builtin_amdgcn_permlane32_swap(__float_as_uint(g),__float_as_uint(g),false,false); g=__uint_as_float(rr_[0])+__uint_as_float(rr_[1]); }
      if(g>v1){v3=v2;i3=i2;v2=v1;i2=i1;v1=g;i1=j;} else if(g>v2){v3=v2;i3=i2;v2=g;i2=j;} else if(g>v3){v3=g;i3=j;} }
    if(i1>=0)selmask|=1u<<i1; if(i2>=0)selmask|=1u<<i2; if(i3>=0)selmask|=1u<<i3; }
  const int wk0=(T0-4*qb)*KVBLK;
  #define BMASK(P0,P1,t) do{ if(!((selmask>>((t)>>2))&1u)){ _Pragma("unroll") for(int r_=0;r_<16;++r_){P0[r_]=-INFINITY;P1[r_]=-INFINITY;} } }while(0)
  #define CMASK(P0,P1,t) do{ if(MODE==1){ wmask(P0,P1,wk0+64*(t),qrel,hi); } else { int jb_=(t)-(NT-4); if(jb_>=0)cmask(P0,P1,jb_,qrel,hi); else BMASK(P0,P1,t); } }while(0)
  bool resc=false;
  #define START(P0,P1) do{ const float rm=rowmax(P0,P1); resc=false; \
    { const float dl=__builtin_fmaxf(rm,-100.f); mhat=fadd_s(mhat,dl); \
      _Pragma("unroll") for(int r=0;r<16;++r){P0[r]=fsub_s(P0[r],dl);P1[r]=fsub_s(P1[r],dl);} \
      _Pragma("unroll") for(int r=0;r<16;++r)negm[r]=-mhat; asm volatile("":"+v"(negm)); } \
    _Pragma("unroll") for(int r=0;r<16;++r)P0[r]=__builtin_amdgcn_exp2f(P0[r]); }while(0)
  #define RESC() do{ if(resc){ asm volatile("s_waitcnt lgkmcnt(0)":::"memory"); \
      _Pragma("unroll") for(int d_=0;d_<2;++d_) _Pragma("unroll") for(int r=0;r<16;++r)o[d_][r]*=wsf[crow(r,hi)]; } }while(0)
  f32x16 pA0,pA1,pB0,pB1;
  int sl_prev=0,sl_cur=0,sl_next=SLOTB;
  #define ROT() do{sl_prev=sl_cur;sl_cur=sl_next;sl_next=(sl_next==(NSLOT-1)*SLOTB)?0:sl_next+SLOTB;}while(0)
  DMA_K(2,2*SLOTB);
  WAIT_BAR(3);
  qkt(pA0,pA1,Kbase,qr,negm,r32,hi);asm volatile("s_nop 15\n\ts_nop 7":"+v"(pA0),"+v"(pA1));CMASK(pA0,pA1,0);
  START(pA0,pA1);
  _Pragma("unroll") for(int r=0;r<16;++r)pA1[r]=__builtin_amdgcn_exp2f(pA1[r]);
  WAIT_BAR(0);
  DMA_K(3,0);DMA_V(1,SLOTB);
  ROT();
  kload8(kf,kp0+sl_cur);
  WAIT_BAR(2);
  s16x4 vlo[8],vhi[8]; u32x4 pw0,pw1,pw2,pw3;
  #define PKW(P,B) cvtpk_s(P[B],P[B+1])
  #define PAF(k) __builtin_bit_cast(bf16x8,pw##k)
  #define VFR(i) (bf16x8){vlo[i][0],vlo[i][1],vlo[i][2],vlo[i][3],vhi[i][0],vhi[i][1],vhi[i][2],vhi[i][3]}
  #define PIN(x) asm volatile("":"+v"(x))
  #define MX3(a,b,c) __builtin_fmaxf(__builtin_fmaxf((a),(b)),(c))
  #define GAPA(MF,A0,A1,A2,A3,W0,W1,PW) do{ MF; sacc+=A0; sacc+=A1; sacc+=A2; sacc+=A3; PIN(sacc); W0; W1; PIN(PW); SBAR(); }while(0)
  #define EX(v) __builtin_amdgcn_exp2f(v)
  #define GAPB(MF,X,B) do{ MF; X[B]=EX(X[B]); X[B+1]=EX(X[B+1]); X[B+2]=EX(X[B+2]); X[B+3]=EX(X[B+3]); PIN(X); SBAR(); }while(0)
  #define VRD(i) do{ vlo[i]=vtr(vp_+(((i)>>2)*4096+((i)&3)*1024)); vhi[i]=vtr(vp_+(((i)>>2)*4096+((i)&3)*1024+512)); }while(0)
  #define KRD(G,j) do{ if(G){ kload2(kf,kp0+sl_next,j); SBAR(); } }while(0)
  #define STEP(C0,C1,P0,P1,t,GK,GV,GL) do{ SBAR(); \
    const lds_cptr vp_=vp0+sl_prev; \
    VRD(0); SBAR(); float sacc=(P0[0]+P0[1]); \
    GAPA(C0=__builtin_amdgcn_mfma_f32_32x32x16_bf16(kf[0],qr[0],negm,0,0,0), P0[2],P0[3],P0[4],P0[5],     pw0[0]=PKW(P0,0), pw0[1]=PKW(P0,2), pw0); \
    VRD(4); SBAR(); GAPA(C1=__builtin_amdgcn_mfma_f32_32x32x16_bf16(kf[1],qr[0],negm,0,0,0), P0[6],P0[7],P0[8],P0[9],     pw0[2]=PKW(P0,4), pw0[3]=PKW(P0,6), pw0); \
    VRD(1); SBAR(); GAPA(C0=__builtin_amdgcn_mfma_f32_32x32x16_bf16(kf[2],qr[1],C0,0,0,0),   P0[10],P0[11],P0[12],P0[13], pw1[0]=PKW(P0,8), pw1[1]=PKW(P0,10), pw1); \
    VRD(5); SBAR(); GAPA(C1=__builtin_amdgcn_mfma_f32_32x32x16_bf16(kf[3],qr[1],C1,0,0,0),   P0[14],P0[15],P1[0],P1[1],   pw1[2]=PKW(P0,12),pw1[3]=PKW(P0,14), pw1); \
    VRD(2); SBAR(); GAPA(C0=__builtin_amdgcn_mfma_f32_32x32x16_bf16(kf[4],qr[2],C0,0,0,0),   P1[2],P1[3],P1[4],P1[5],     pw2[0]=PKW(P1,0), pw2[1]=PKW(P1,2), pw2); \
    VRD(6); SBAR(); GAPA(C1=__builtin_amdgcn_mfma_f32_32x32x16_bf16(kf[5],qr[2],C1,0,0,0),   P1[6],P1[7],P1[8],P1[9],     pw2[2]=PKW(P1,4), pw2[3]=PKW(P1,6), pw2); \
    VRD(3); SBAR(); GAPA(C0=__builtin_amdgcn_mfma_f32_32x32x16_bf16(kf[6],qr[3],C0,0,0,0),   P1[10],P1[11],P1[12],P1[13], pw3[0]=PKW(P1,8), pw3[1]=PKW(P1,10), pw3); \
    VRD(7); SBAR(); GAPA(C1=__builtin_amdgcn_mfma_f32_32x32x16_bf16(kf[7],qr[3],C1,0,0,0),   P1[14],P1[15],0.f,0.f,       pw3[2]=PKW(P1,12),pw3[3]=PKW(P1,14), pw3); \
    l_reg+=sacc; \
    if(GK){DMA_K((t)+3,sl_cur);} if(GV){DMA_V((t)+1,sl_next);} \
    CMASK(C0,C1,t); \
    { float a=MX3(C0[0],C0[1],C1[0]),b=MX3(C0[2],C0[3],C1[1]); a=MX3(a,C1[2],C1[3]); \
      _Pragma("unroll") for(int r=4;r<16;r+=4){a=MX3(a,C0[r],C0[r+1]);b=MX3(b,C0[r+2],C0[r+3]);a=MX3(a,C1[r],C1[r+1]);b=MX3(b,C1[r+2],C1[r+3]);} \
      float rm=__builtin_fmaxf(a,b); { auto rr=__builtin_amdgcn_permlane32_swap(__float_as_uint(rm),__float_as_uint(rm),false,false); rm=__builtin_fmaxf(__uint_as_float(rr[0]),__uint_as_float(rr[1])); } \
      resc=false; \
      if(__builtin_expect(__any(rm>(float)THRL),0)){ const float dl=__builtin_fmaxf(rm,0.f); mhat+=dl; \
        _Pragma("unroll") for(int r=0;r<16;++r){C0[r]-=dl;C1[r]-=dl;} \
        _Pragma("unroll") for(int r=0;r<16;++r)negm[r]=-mhat; asm volatile("":"+v"(negm)); \
        const float f=__builtin_amdgcn_exp2f(-dl); l_reg*=f; if(hi==0)wsf[r32]=f; resc=true; } } \
    SBAR(); \
    GAPB(o[0]=__builtin_amdgcn_mfma_f32_32x32x16_bf16(PAF(0),VFR(0),o[0],0,0,0), C0,0); \
    GAPB(o[1]=__builtin_amdgcn_mfma_f32_32x32x16_bf16(PAF(0),VFR(4),o[1],0,0,0), C0,4); \
    KRD(GL,0); GAPB(o[0]=__builtin_amdgcn_mfma_f32_32x32x16_bf16(PAF(1),VFR(1),o[0],0,0,0), C0,8); \
    KRD(GL,1); GAPB(o[1]=__builtin_amdgcn_mfma_f32_32x32x16_bf16(PAF(1),VFR(5),o[1],0,0,0), C0,12); \
    KRD(GL,2); GAPB(o[0]=__builtin_amdgcn_mfma_f32_32x32x16_bf16(PAF(2),VFR(2),o[0],0,0,0), C1,0); \
    KRD(GL,3); GAPB(o[1]=__builtin_amdgcn_mfma_f32_32x32x16_bf16(PAF(2),VFR(6),o[1],0,0,0), C1,4); \
    GAPB(o[0]=__builtin_amdgcn_mfma_f32_32x32x16_bf16(PAF(3),VFR(3),o[0],0,0,0), C1,8); \
    GAPB(o[1]=__builtin_amdgcn_mfma_f32_32x32x16_bf16(PAF(3),VFR(7),o[1],0,0,0), C1,12); \
    }while(0)
  int t=1;
  #undef CMASK
  #define CMASK(P0,P1,t) do{ if(MODE==0)BMASK(P0,P1,t); }while(0)
  for(;t+5<NT;t+=2){
    STEP(pB0,pB1,pA0,pA1,t,true,true,true);     WAIT_BAR(2); RESC(); ROT();
    STEP(pA0,pA1,pB0,pB1,t+1,true,true,true);   WAIT_BAR(2); RESC(); ROT();
  }
  #undef CMASK
  #define CMASK(P0,P1,t) do{ if(MODE==1){ wmask(P0,P1,wk0+64*(t),qrel,hi); } else { int jb_=(t)-(NT-4); if(jb_>=0)cmask(P0,P1,jb_,qrel,hi); else BMASK(P0,P1,t); } }while(0)
  #define ENDW(tt) do{ if((tt)+3<NT){WAIT_BAR(2);} else if((tt)+2<NT){WAIT_BAR(1);} else {WAIT_BAR(0);} }while(0)
  for(;t+1<NT;t+=2){
    STEP(pB0,pB1,pA0,pA1,t,(t+3<NT),(t+1<NT),(t+1<NT));       ENDW(t);   RESC(); ROT();
    STEP(pA0,pA1,pB0,pB1,t+1,(t+4<NT),(t+2<NT),(t+2<NT));     ENDW(t+1); RESC(); ROT();
  }
  STEP(pB0,pB1,pA0,pA1,NT-1,false,false,false); RESC();
  { float sacc=pB0[0]+pB0[1]; _Pragma("unroll") for(int r=2;r<16;++r)sacc+=pB0[r]; _Pragma("unroll") for(int r=0;r<16;++r)sacc+=pB1[r]; l_reg+=sacc;
    pw0=(u32x4){PKW(pB0,0),PKW(pB0,2),PKW(pB0,4),PKW(pB0,6)};pw1=(u32x4){PKW(pB0,8),PKW(pB0,10),PKW(pB0,12),PKW(pB0,14)};pw2=(u32x4){PKW(pB1,0),PKW(pB1,2),PKW(pB1,4),PKW(pB1,6)};pw3=(u32x4){PKW(pB1,8),PKW(pB1,10),PKW(pB1,12),PKW(pB1,14)};
    SBAR(); pv(o,vb0+sl_cur,PAF(0),PAF(1),PAF(2),PAF(3)); }
  #undef PKW
  #undef PAF
  #undef VFR
  #undef PIN
  #undef MX3
  #undef GAPA
  #undef GAPB
  #undef EX
  #undef VRD
  #undef KRD
  #undef STEP
  #undef ENDW
  {auto rr=__builtin_amdgcn_permlane32_swap(__float_as_uint(l_reg),__float_as_uint(l_reg),false,false);l_reg=__uint_as_float(rr[0])+__uint_as_float(rr[1]);}
  if(MODE==1)l_reg+=__builtin_amdgcn_exp2f(sink2-mhat);
  if(hi==0)wsf[32+r32]=l_reg;asm volatile("s_waitcnt lgkmcnt(0)":::"memory");
  float rli[16];
  #pragma unroll
  for(int r=0;r<16;++r)rli[r]=__builtin_amdgcn_rcpf(wsf[32+crow(r,hi)]);
  bf16*Ow=O+(rowbase+q0+wid*QBLK)*QP+qcol;
  { bf16*stg=(bf16*)(shm+LDS_OST)+wid*2048;
    #pragma unroll
    for(int r=0;r<16;++r){const int orow=crow(r,hi);
      #pragma unroll
      for(int d0=0;d0<2;++d0)stg[orow*64+d0*32+r32]=__float2bfloat16(o[d0][r]*rli[r]);}
    asm volatile("s_waitcnt lgkmcnt(0)":::"memory");
    #pragma unroll
    for(int i=0;i<4;++i){const int row=i*8+(lane>>3),ch=lane&7; const u32x4 v=*(const u32x4*)(stg+row*64+ch*8); ATTN_STORE16(Ow+(long)row*QP+ch*8,v);} }
  asm volatile("s_waitcnt lgkmcnt(0)\n\ts_barrier":::"memory");
  #undef DMA_K
  #undef DMA_V
  #undef CMASK
  #undef BMASK
  #undef START
  #undef RESC
  #undef ROT
}
constexpr int ATTN_LDS_BYTES=LDS_BYTES;
#undef SBAR
#undef WAIT_BAR
}

#include <hip/hip_cooperative_groups.h>
namespace cg = cooperative_groups;
#define LAS __attribute__((address_space(3)))
typedef pg8::f32x4 f32x4;
typedef unsigned u32x4 __attribute__((ext_vector_type(4)));
typedef unsigned u32x2 __attribute__((ext_vector_type(2)));
typedef float f32x2_t __attribute__((ext_vector_type(2))); typedef __bf16 bf16x2_t __attribute__((ext_vector_type(2)));
DEVI unsigned pk2(float lo, float hi) { f32x2_t v = {lo, hi}; bf16x2_t b = __builtin_convertvector(v, bf16x2_t); return __builtin_bit_cast(unsigned, b); }
DEVI float bflo(unsigned u) { return __uint_as_float(u << 16); }
DEVI float bfhi(unsigned u) { return __uint_as_float(u & 0xffff0000u); }

DEVI int mk_lane_id() { int l; asm volatile("v_mbcnt_lo_u32_b32 %0, -1, 0\n\tv_mbcnt_hi_u32_b32 %0, -1, %0" : "=v"(l)); return l; }
DEVI float bperm_xor(float v, int lane, int mask) { return __int_as_float(__builtin_amdgcn_ds_bpermute((lane ^ mask) << 2, __float_as_int(v))); }
DEVI float wave_sum_l(float v, int lane) {
#pragma unroll
    for (int o = 1; o < 64; o <<= 1) v += bperm_xor(v, lane, o);
    return v;
}
constexpr size_t WO_IN = 0, WO_GATE = 6815744, WO_BR = WO_GATE + 6 * MiB, WO_OUT = WO_BR + 3 * MiB, WO_FF1 = WO_OUT + 2 * MiB, WO_FF2 = WO_FF1 + 8 * MiB;
static_assert(WO_FF2 + 8 * MiB <= 34 * MiB, "W region");
constexpr int NPERM = 3328;

DEVI int win_src_col(int np) {
    int s0, nat, rope;
    if (np < 512) { s0 = 0; nat = 0; rope = 1; }
    else if (np < 576) { s0 = 512; nat = 512; rope = 1; }
    else if (np < 640) { s0 = 576; nat = 576; rope = 0; }
    else if (np < 896) { s0 = 640; nat = 640; rope = 1; }
    else if (np < 960) { s0 = 896; nat = 896; rope = 1; }
    else if (np < 1472) { s0 = 960; nat = 964; rope = 1; }
    else if (np < 1600) { s0 = 1472; nat = 1476; rope = 1; }
    else if (np < 1728) { s0 = 1600; nat = 1604; rope = 0; }
    else if (np < 2240) { s0 = 1728; nat = 1732; rope = 1; }
    else if (np < 2752) { s0 = 2240; nat = 2244; rope = 1; }
    else if (np < 3264) { s0 = 2752; nat = 2756; rope = 0; }
    else { const int r = np - 3264; return (r < 4) ? 960 + r : -1; }
    const int r = np - s0;
    if (!rope) return nat + r;
    const int hb = r >> 6, w = r & 63;
    return nat + 64 * hb + (w >> 1) + 32 * (w & 1);
}
struct MapWin { DEVI int operator()(int n) const { return win_src_col(n); } };
struct MapOff { int off; DEVI int operator()(int n) const { return off + n; } };

struct TrItem { const float* W; bf16_t* WT; int ldw, K, k0, n0, sc; };
DEVI void tr_load(const TrItem& t, float (&v)[32], int lane) {
    const float* p = t.W + (size_t)(t.k0 + (lane >> 5)) * t.ldw + (t.sc >= 0 ? t.sc : 0);
    const unsigned msk = (t.sc >= 0) ? 0xffffffffu : 0u;
#pragma unroll
    for (int i = 0; i < 32; ++i) v[i] = __uint_as_float(__float_as_uint(p[(size_t)(2 * i) * t.ldw]) & msk);
}
DEVI void tr_store(const TrItem& t, const float (&v)[32], LAS float* scr, int lane) {
#pragma unroll
    for (int i = 0; i < 32; ++i) scr[(2 * i + (lane >> 5)) * 33 + (lane & 31)] = v[i];
    asm volatile("s_waitcnt lgkmcnt(0)" ::: "memory");
    const int c = lane & 7;
#pragma unroll
    for (int j = 0; j < 4; ++j) {
        const int n = (lane >> 3) + 8 * j; const LAS float* s = scr + (8 * c) * 33 + n;
        u32x4 o; o.x = pk2(s[0 * 33], s[1 * 33]); o.y = pk2(s[2 * 33], s[3 * 33]); o.z = pk2(s[4 * 33], s[5 * 33]); o.w = pk2(s[6 * 33], s[7 * 33]);
        *(u32x4*)(t.WT + (size_t)(t.n0 + n) * t.K + t.k0 + 8 * c) = o;
    }
    asm volatile("s_waitcnt lgkmcnt(0)" ::: "memory");
}

constexpr int RSTD_TAB_OFF = 131072;
template <class Sched>
DEVI void fill_rstd_table(const Sched& S, const float* SSQ, LAS unsigned char* lds, int tid) {
    LAS float* tab = (LAS float*)(lds + RSTD_TAB_OFF);
#pragma unroll
    for (int k = 0; k < 2; ++k) {
        const int i = (tid >> 8) + 2 * k; pg8::Unit u;
        if (S.next(i, u)) tab[i * 256 + (tid & 255)] = rstd_of(SSQ, u.pm * 256 + (tid & 255));
    }
    asm volatile("s_waitcnt lgkmcnt(0)" ::: "memory"); __builtin_amdgcn_s_barrier();
}
struct EpiProjMK {
    static constexpr bool PERM = true, AFTER_DRAIN = false, PROBE_DBL = false;
    const LAS float* tab; unsigned char* ws; const float* COS; const float* SIN;
    DEVI void operator()(const f32x4 (&acc)[2][2][4][2], const pg8::Unit& u, int wr, int wc, int fr, int fq) const {
        const int row0 = u.pm * 256 + wr * 64 + fr;
        const int j = 4 * (wc & 1) + fq;
        f32x4 ks1[2], ks2[2];
#pragma unroll
        for (int bj = 0; bj < 2; ++bj) { ks1[bj] = (f32x4){0.f, 0.f, 0.f, 0.f}; ks2[bj] = ks1[bj]; }
#pragma unroll
        for (int ai = 0; ai < 2; ++ai) {
            f32x4 c4[4], s4[4]; float rs[4];
#pragma unroll
            for (int m = 0; m < 4; ++m) {
                const int row = row0 + ai * 128 + m * 16, pos = row & (SEQ - 1);
                c4[m] = *(const f32x4*)(COS + pos * 32 + 4 * j); s4[m] = *(const f32x4*)(SIN + pos * 32 + 4 * j);
                rs[m] = tab[u.ord * 256 + wr * 64 + fr + ai * 128 + m * 16];
            }
#pragma unroll
            for (int bj = 0; bj < 2; ++bj) {
                const int np0 = (4 * u.pn + 2 * bj + (wc >> 1)) * 64;
                size_t off; int pitch, dcol, mode;
                if (np0 < 512) { off = WS_AQ; pitch = 512; dcol = np0; mode = 2; }
                else if (np0 < 576) { off = WS_AK; pitch = 64; dcol = 0; mode = 1; }
                else if (np0 < 640) { off = WS_AV; pitch = 64; dcol = 0; mode = 0; }
                else if (np0 < 896) { off = WS_IQ; pitch = 256; dcol = np0 - 640; mode = 1; }
                else if (np0 < 960) { off = WS_IK; pitch = 64; dcol = 0; mode = 1; }
                else if (np0 < 1472) { off = WS_BQ; pitch = 512; dcol = np0 - 960; mode = 2; }
                else if (np0 < 1600) { off = WS_BK; pitch = 128; dcol = np0 - 1472; mode = 1; }
                else if (np0 < 1728) { off = WS_BV; pitch = 128; dcol = np0 - 1600; mode = 0; }
                else if (np0 < 2240) { off = WS_CQ; pitch = 512; dcol = np0 - 1728; mode = 2; }
                else if (np0 < 2752) { off = WS_CK; pitch = 512; dcol = np0 - 2240; mode = 1; }
                else if (np0 < 3264) { off = WS_CV; pitch = 512; dcol = np0 - 2752; mode = 0; }
                else { off = WS_IW; pitch = 4; dcol = 0; mode = 3; }
                bf16_t* dst = (bf16_t*)(ws + off);
                const float sc = (mode == 2) ? C2 : 1.0f;
#pragma unroll
                for (int m = 0; m < 4; ++m) {
                    const int row = row0 + ai * 128 + m * 16;
                    const f32x4 v0 = acc[ai][bj][m][0] * rs[m], v1 = acc[ai][bj][m][1] * rs[m];
                    if (mode == 0) {
                        u32x4 w; w.x = pk2(v0[0], v0[1]); w.y = pk2(v0[2], v0[3]); w.z = pk2(v1[0], v1[1]); w.w = pk2(v1[2], v1[3]);
                        *(u32x4*)(dst + (size_t)row * pitch + dcol + 8 * j) = w;
                    } else if (mode == 3) {
                        if (j == 0) *(f32x4*)((float*)(ws + off) + (size_t)row * 4) = v0;
                    } else {
                        const f32x4 x1 = {v0[0], v0[2], v1[0], v1[2]}, x2 = {v0[1], v0[3], v1[1], v1[3]};
                        const f32x4 o1 = (x1 * c4[m] - x2 * s4[m]) * sc, o2 = (x1 * s4[m] + x2 * c4[m]) * sc;
                        u32x2 a, b; a.x = pk2(o1[0], o1[1]); a.y = pk2(o1[2], o1[3]); b.x = pk2(o2[0], o2[1]); b.y = pk2(o2[2], o2[3]);
                        bf16_t* p = dst + (size_t)row * pitch + dcol + 4 * j;
                        *(u32x2*)p = a; *(u32x2*)(p + 32) = b;
                        if (off == WS_CK) { ks1[bj] += o1; ks2[bj] += o2; }
                    }
                }
            }
            asm volatile("" ::: "memory");
        }
#pragma unroll
        for (int bj = 0; bj < 2; ++bj) {
            const int np0 = (4 * u.pn + 2 * bj + (wc >> 1)) * 64;
            if (np0 >= 2240 && np0 < 2752) {
                const int ln = fq * 16 + fr;
#pragma unroll
                for (int e = 0; e < 4; ++e) {
                    float a = ks1[bj][e], b = ks2[bj][e];
#pragma unroll
                    for (int o = 1; o < 16; o <<= 1) { a += bperm_xor(a, ln, o); b += bperm_xor(b, ln, o); }
                    ks1[bj][e] = a; ks2[bj][e] = b;
                }
                if (fr == 0) {
                    float* km = (float*)(ws + WS_KMEAN) + ((size_t)((u.pm >> 5) * 8 + ((np0 - 2240) >> 6)) * 32 + (u.pm & 31)) * 64 + 4 * j;
#pragma unroll
                    for (int e = 0; e < 4; ++e) { atomicAdd(km + e, ks1[bj][e] * (1.0f / 256.0f)); atomicAdd(km + 32 + e, ks2[bj][e] * (1.0f / 256.0f)); }
                }
            }
        }
    }
};
template <int ACT> struct EpiActMK {
    static constexpr bool PERM = true, AFTER_DRAIN = false, PROBE_DBL = (ACT == 1);
    const LAS float* tab; void* Ov; int ldc;
    DEVI void operator()(const f32x4 (&acc)[2][2][4][2], const pg8::Unit& u, int wr, int wc, int fr, int fq) const {
        const int row0 = u.pm * 256 + wr * 64 + fr, col0 = u.pn * 256 + wc * 32 + 8 * fq;
#pragma unroll
        for (int ai = 0; ai < 2; ++ai)
#pragma unroll
            for (int m = 0; m < 4; ++m) {
                const int row = row0 + ai * 128 + m * 16; float rs = tab[u.ord * 256 + wr * 64 + fr + ai * 128 + m * 16];
                if (ACT == 0) rs *= -LOG2E;
#pragma unroll
                for (int bj = 0; bj < 2; ++bj) {
                    float v[8];
#pragma unroll
                    for (int e = 0; e < 4; ++e) { v[e] = acc[ai][bj][m][0][e] * rs; v[4 + e] = acc[ai][bj][m][1][e] * rs; }
                    if constexpr (ACT == 0) {
#pragma unroll
                        for (int e = 0; e < 8; ++e) v[e] = 255.0f * __builtin_amdgcn_rcpf(1.0f + __builtin_amdgcn_exp2f(v[e]));
                        unsigned lo = 0u, hi = 0u;
                        lo = __builtin_amdgcn_cvt_pk_u8_f32(v[0], 0, lo); lo = __builtin_amdgcn_cvt_pk_u8_f32(v[1], 1, lo); lo = __builtin_amdgcn_cvt_pk_u8_f32(v[2], 2, lo); lo = __builtin_amdgcn_cvt_pk_u8_f32(v[3], 3, lo);
                        hi = __builtin_amdgcn_cvt_pk_u8_f32(v[4], 0, hi); hi = __builtin_amdgcn_cvt_pk_u8_f32(v[5], 1, hi); hi = __builtin_amdgcn_cvt_pk_u8_f32(v[6], 2, hi); hi = __builtin_amdgcn_cvt_pk_u8_f32(v[7], 3, hi);
                        u32x2 w; w.x = lo; w.y = hi;
                        *(u32x2*)((unsigned char*)Ov + (size_t)row * ldc + col0 + bj * 128) = w;
                    } else {
#pragma unroll
                        for (int e = 0; e < 8; ++e) { const float t = fmaxf(v[e], 0.f); v[e] = t * t; }
                        u32x4 w; w.x = pk2(v[0], v[1]); w.y = pk2(v[2], v[3]); w.z = pk2(v[4], v[5]); w.w = pk2(v[6], v[7]);
                        *(u32x4*)((bf16_t*)Ov + (size_t)row * ldc + col0 + bj * 128) = w;
                    }
                }
            }
    }
};
struct BranchOrder {
    pg8::StaticOrder S; int gm, gpm, gj;
    __device__ bool next(int i, pg8::Unit& u) const { pg8::Unit t; const int ti = i / 3, br = i - 3 * ti;
        if (gm) { if (ti != 0) return false; t.pm = gpm; t.pn = gj; } else if (!S.next(ti, t)) return false;
        u.pm = 64 * br + t.pm; u.pn = 4 * br + t.pn; u.ord = br; return true; }
    DEVI void a_ready(const pg8::Unit&) const {}
    DEVI void done(const pg8::Unit&) const {}
};
struct EpiBranchMK {
    static constexpr bool PERM = true, AFTER_DRAIN = false, PROBE_DBL = false;
    const unsigned char* GS; bf16_t* MG;
    DEVI void operator()(const f32x4 (&acc)[2][2][4][2], const pg8::Unit& u, int wr, int wc, int fr, int fq) const {
        const int br = u.ord;
        const int row0 = (u.pm - 64 * br) * 256 + wr * 64 + fr, col0 = (u.pn - 4 * br) * 256 + wc * 32 + 8 * fq;
#pragma unroll
        for (int ai = 0; ai < 2; ++ai) {
            u32x2 gg[4][2]; u32x4 oo[4][2];
#pragma unroll
            for (int m = 0; m < 4; ++m)
#pragma unroll
                for (int bj = 0; bj < 2; ++bj) {
                    const int row = row0 + ai * 128 + m * 16, col = col0 + bj * 128;
                    gg[m][bj] = *(const u32x2*)(GS + (size_t)row * 3072 + br * 1024 + col);
                    oo[m][bj] = (br > 0) ? *(const u32x4*)(MG + (size_t)row * 1024 + col) : (u32x4){0u, 0u, 0u, 0u};
                }
#pragma unroll
            for (int m = 0; m < 4; ++m)
#pragma unroll
                for (int bj = 0; bj < 2; ++bj) {
                    const int row = row0 + ai * 128 + m * 16, col = col0 + bj * 128;
                    const u32x2 g = gg[m][bj]; const u32x4 o = oo[m][bj];
                    const float k = 1.0f / 255.0f;
                    float v[8];
                    v[0] = (float)(g.x & 0xffu) * k * acc[ai][bj][m][0][0]; v[1] = (float)((g.x >> 8) & 0xffu) * k * acc[ai][bj][m][0][1];
                    v[2] = (float)((g.x >> 16) & 0xffu) * k * acc[ai][bj][m][0][2]; v[3] = (float)(g.x >> 24) * k * acc[ai][bj][m][0][3];
                    v[4] = (float)(g.y & 0xffu) * k * acc[ai][bj][m][1][0]; v[5] = (float)((g.y >> 8) & 0xffu) * k * acc[ai][bj][m][1][1];
                    v[6] = (float)((g.y >> 16) & 0xffu) * k * acc[ai][bj][m][1][2]; v[7] = (float)(g.y >> 24) * k * acc[ai][bj][m][1][3];
                    if (br > 0) { v[0] += bflo(o.x); v[1] += bfhi(o.x); v[2] += bflo(o.y); v[3] += bfhi(o.y); v[4] += bflo(o.z); v[5] += bfhi(o.z); v[6] += bflo(o.w); v[7] += bfhi(o.w); }
                    u32x4 w; w.x = pk2(v[0], v[1]); w.y = pk2(v[2], v[3]); w.z = pk2(v[4], v[5]); w.w = pk2(v[6], v[7]);
                    *(u32x4*)(MG + (size_t)row * 1024 + col) = w;
                }
            asm volatile("" ::: "memory");
        }
    }
};
struct EpiResMK {
    static constexpr bool PERM = true, AFTER_DRAIN = false, PROBE_DBL = false;
    const float* xin; float* out; const float* g; bf16_t* XG; float* SSQ;
    DEVI void operator()(const f32x4 (&acc)[2][2][4][2], const pg8::Unit& u, int wr, int wc, int fr, int fq) const {
        const int row0 = u.pm * 256 + wr * 64 + fr, col0 = u.pn * 256 + wc * 32 + 8 * fq;
        f32x4 gv[2][2];
#pragma unroll
        for (int bj = 0; bj < 2; ++bj) { if (g) { gv[bj][0] = *(const f32x4*)(g + col0 + bj * 128); gv[bj][1] = *(const f32x4*)(g + col0 + bj * 128 + 4); } else { gv[bj][0] = (f32x4){1.f, 1.f, 1.f, 1.f}; gv[bj][1] = gv[bj][0]; } }
#pragma unroll
        for (int ai = 0; ai < 2; ++ai)
#pragma unroll
        for (int mh = 0; mh < 2; ++mh) {
            f32x4 xr[2][2][2];
#pragma unroll
            for (int mm = 0; mm < 2; ++mm)
#pragma unroll
                for (int bj = 0; bj < 2; ++bj) { const size_t o = (size_t)(row0 + ai * 128 + (2 * mh + mm) * 16) * 1024 + col0 + bj * 128; xr[mm][bj][0] = *(const f32x4*)(xin + o); xr[mm][bj][1] = *(const f32x4*)(xin + o + 4); }
#pragma unroll
            for (int mm = 0; mm < 2; ++mm) {
                const int m = 2 * mh + mm;
                const int row = row0 + ai * 128 + m * 16;
                float s = 0.f;
#pragma unroll
                for (int bj = 0; bj < 2; ++bj) {
                    const size_t o = (size_t)row * 1024 + col0 + bj * 128;
                    const f32x4 y0 = xr[mm][bj][0] + acc[ai][bj][m][0], y1 = xr[mm][bj][1] + acc[ai][bj][m][1];
                    *(f32x4*)(out + o) = y0; *(f32x4*)(out + o + 4) = y1;
                    s += (y0[0] * y0[0] + y0[1] * y0[1]) + (y0[2] * y0[2] + y0[3] * y0[3]) + (y1[0] * y1[0] + y1[1] * y1[1]) + (y1[2] * y1[2] + y1[3] * y1[3]);
                    if (g) {
                        const f32x4 z0 = y0 * gv[bj][0], z1 = y1 * gv[bj][1];
                        u32x4 w; w.x = pk2(z0[0], z0[1]); w.y = pk2(z0[2], z0[3]); w.z = pk2(z1[0], z1[1]); w.w = pk2(z1[2], z1[3]);
                        *(u32x4*)(XG + o) = w;
                    }
                }
                { const int ln = fq * 16 + fr; s += bperm_xor(s, ln, 16); s += bperm_xor(s, ln, 32); }
                if (fq == 0) SSQ[(size_t)row * 16 + u.pn * 4 + wc] = s;
            }
            asm volatile("" ::: "memory");
        }
    }
};


#define XB_TMO      128
#define XB_XCNT(j)  (256  + 64 * (j))
#define XB_XSUB(j)  (1280 + 64 * (j))
#define XB_XGEN(j)  (2304 + 64 * (j))
#define XB_TOP      3328
#define XB_TOPGEN   3392
#define XB_SLOT(b)  (4096 + 2 * (b))
#define XB_SPIN_CAP (1u << 20)
constexpr size_t CTL_ZERO_BYTES = 32768;
DEVI unsigned xb_ld(unsigned* p)              { return __hip_atomic_load(p, __ATOMIC_RELAXED, __HIP_MEMORY_SCOPE_AGENT); }
DEVI unsigned xb_add(unsigned* p, unsigned v) { return __hip_atomic_fetch_add(p, v, __ATOMIC_RELAXED, __HIP_MEMORY_SCOPE_AGENT); }
DEVI unsigned xb_xcc_id() { return (unsigned)__builtin_amdgcn_s_getreg((3 << 11) | 20) & 0xFu; }
#define XB_SPIN(cond, bar) do { unsigned _sp = 0; while (cond) { __builtin_amdgcn_s_sleep(1); \
    if ((++_sp & 255u) == 0u) { if (xb_ld(&(bar)[XB_TMO])) break; if (_sp > XB_SPIN_CAP) { atomicAdd(&(bar)[XB_TMO], 1u); break; } } } } while (0)
DEVI void xcd_barrier_complete(unsigned* bar, unsigned x, unsigned& nloc, unsigned& nx) {
    const unsigned G = gridDim.x * gridDim.y * gridDim.z;
    unsigned sum, cnt, mine, sp = 0u;
    for (;;) {
        sum = 0u; cnt = 0u; mine = 0u;
#pragma unroll
        for (unsigned j = 0; j < 16; ++j) { const unsigned c = xb_ld(&bar[XB_XCNT(j)]); sum += c; cnt += (c > 0u) ? 1u : 0u; mine = (j == x) ? c : mine; }
        if (sum == G) break;
        __builtin_amdgcn_s_sleep(1);
        if ((++sp & 255u) == 0u) { if (xb_ld(&bar[XB_TMO])) break; if (sp > XB_SPIN_CAP) { atomicAdd(&bar[XB_TMO], 1u); break; } }
    }
    nloc = mine > 0u ? mine : 1u; nx = cnt > 0u ? cnt : 1u;
}
DEVI void xcd_barrier(unsigned* bar, bool tid0) {
    asm volatile("s_waitcnt vmcnt(0)" ::: "memory");
    __syncthreads();
    if (tid0) {
        __builtin_amdgcn_s_waitcnt(0);
        const unsigned x = xb_xcc_id();
        volatile unsigned* st = bar + XB_SLOT(blockIdx.x);
        unsigned nloc = st[0], nx = st[1];
        if (nloc == 0u) { xcd_barrier_complete(bar, x, nloc, nx); st[0] = nloc; st[1] = nx; }
        const unsigned old = xb_add(&bar[XB_XSUB(x)], 1u);
        const unsigned gen = old / nloc;
        if (old + 1u == (gen + 1u) * nloc) {
            __builtin_amdgcn_fence(__ATOMIC_RELEASE, "agent");
            asm volatile("s_waitcnt vmcnt(0)" ::: "memory");
            const unsigned og = xb_add(&bar[XB_TOP], 1u);
            const unsigned tg = og / nx;
            if (og + 1u == (tg + 1u) * nx) xb_add(&bar[XB_TOPGEN], 1u);
            else XB_SPIN(xb_ld(&bar[XB_TOPGEN]) == tg, bar);
            __builtin_amdgcn_fence(__ATOMIC_ACQUIRE, "agent");
            xb_add(&bar[XB_XGEN(x)], 1u);
            asm volatile("s_waitcnt vmcnt(0)" ::: "memory");
        } else {
            XB_SPIN(xb_ld(&bar[XB_XGEN(x)]) == gen, bar);
            __builtin_amdgcn_fence(__ATOMIC_ACQUIRE, "agent");
            asm volatile("s_waitcnt vmcnt(0)" ::: "memory");
        }
    }
    __syncthreads();
}

DEVI void group_sync(unsigned* bar, unsigned* ctr, unsigned target, bool tid0) {
    asm volatile("s_waitcnt vmcnt(0)" ::: "memory");
    __syncthreads();
    if (tid0) {
        __builtin_amdgcn_s_waitcnt(0);
        xb_add(ctr, 1u);
        XB_SPIN(xb_ld(ctr) < target, bar);
        __builtin_amdgcn_fence(__ATOMIC_ACQUIRE, "agent");
        asm volatile("s_waitcnt vmcnt(0)" ::: "memory");
    }
    __syncthreads();
}

struct EpiResFinalMK {
    static constexpr bool PERM = true, AFTER_DRAIN = true, PROBE_DBL = false;
    const float* xin; float* out; const float* gf; float* SSQ; unsigned* bar; unsigned* gctr; unsigned gtarget;
    DEVI void fused(f32x4 (&acc)[2][2][4][2], const pg8::Unit& u, int wr, int wc, int fr, int fq, LAS unsigned char*, int wid, int lane) const {
        const int row0 = u.pm * 256 + wr * 64 + fr, col0 = u.pn * 256 + wc * 32 + 8 * fq;
#pragma unroll
        for (int ai = 0; ai < 2; ++ai)
#pragma unroll
        for (int mh = 0; mh < 2; ++mh) {
            f32x4 xr[2][2][2];
#pragma unroll
            for (int mm = 0; mm < 2; ++mm)
#pragma unroll
                for (int bj = 0; bj < 2; ++bj) { const size_t o = (size_t)(row0 + ai * 128 + (2 * mh + mm) * 16) * 1024 + col0 + bj * 128; xr[mm][bj][0] = *(const f32x4*)(xin + o); xr[mm][bj][1] = *(const f32x4*)(xin + o + 4); }
#pragma unroll
            for (int mm = 0; mm < 2; ++mm) {
                const int m = 2 * mh + mm;
                const int row = row0 + ai * 128 + m * 16;
                float s = 0.f;
#pragma unroll
                for (int bj = 0; bj < 2; ++bj) {
                    const f32x4 y0 = xr[mm][bj][0] + acc[ai][bj][m][0], y1 = xr[mm][bj][1] + acc[ai][bj][m][1];
                    acc[ai][bj][m][0] = y0; acc[ai][bj][m][1] = y1;
                    s += (y0[0] * y0[0] + y0[1] * y0[1]) + (y0[2] * y0[2] + y0[3] * y0[3]) + (y1[0] * y1[0] + y1[1] * y1[1]) + (y1[2] * y1[2] + y1[3] * y1[3]);
                }
                { const int ln = fq * 16 + fr; s += bperm_xor(s, ln, 16); s += bperm_xor(s, ln, 32); }
                if (fq == 0) SSQ[(size_t)row * 16 + u.pn * 4 + wc] = s;
            }
            asm volatile("" ::: "memory");
        }
        if (gctr) group_sync(bar, gctr, gtarget, wid == 0 && lane == 0); else xcd_barrier(bar, wid == 0 && lane == 0);
        f32x4 gv[2][2];
#pragma unroll
        for (int bj = 0; bj < 2; ++bj) { gv[bj][0] = *(const f32x4*)(gf + col0 + bj * 128); gv[bj][1] = *(const f32x4*)(gf + col0 + bj * 128 + 4); }
#pragma unroll
        for (int ai = 0; ai < 2; ++ai)
#pragma unroll
            for (int m = 0; m < 4; ++m) {
                const int row = row0 + ai * 128 + m * 16; const float rs = rstd_of(SSQ, row);
#pragma unroll
                for (int bj = 0; bj < 2; ++bj) {
                    const size_t o = (size_t)row * 1024 + col0 + bj * 128;
                    *(f32x4*)(out + o) = acc[ai][bj][m][0] * rs * gv[bj][0]; *(f32x4*)(out + o + 4) = acc[ai][bj][m][1] * rs * gv[bj][1];
                }
            }
    }
};

namespace dsa {
typedef short bf16x8 __attribute__((ext_vector_type(8)));
typedef short s16x4 __attribute__((ext_vector_type(4)));
typedef float f32x4 __attribute__((ext_vector_type(4)));
typedef unsigned u32x4 __attribute__((ext_vector_type(4)));
typedef __attribute__((address_space(3))) unsigned lds_u32;
typedef __attribute__((address_space(3))) unsigned short lds_u16;
typedef __attribute__((address_space(3))) unsigned char lds_u8;
constexpr int WAVE_LDS = 16384;
constexpr int OFF_SEL = 14336;
constexpr int OFF_STG = 8 * WAVE_LDS;
constexpr int STG_BYTES = 16384;
constexpr int DSA_LDS = OFF_STG + 2 * STG_BYTES;
constexpr int VROW = 144;

DEVI int bperm_i(int v, int srclane) { return __builtin_amdgcn_ds_bpermute(srclane << 2, v); }

DEVI void chunk_scores(unsigned (&u)[4], const bf16x8 (&bfr)[4][2], const bf16x8& a0, const bf16x8& a1, const f32x4& w) {
    f32x4 cc[4];
#pragma unroll
    for (int t = 0; t < 4; ++t) cc[t] = __builtin_amdgcn_mfma_f32_16x16x32_bf16(a0, bfr[t][0], (f32x4){0.f, 0.f, 0.f, 0.f}, 0, 0, 0);
#pragma unroll
    for (int t = 0; t < 4; ++t) cc[t] = __builtin_amdgcn_mfma_f32_16x16x32_bf16(a1, bfr[t][1], cc[t], 0, 0, 0);
#pragma unroll
    for (int t = 0; t < 4; ++t) {
        const f32x4 c = cc[t];
        float r0, r1, r2, r3;
        { int i0_ = __float_as_int(c[0]), i1_ = __float_as_int(c[1]), i2_ = __float_as_int(c[2]), i3_ = __float_as_int(c[3]);
          r0 = __int_as_float(i0_ > 0 ? i0_ : 0); r1 = __int_as_float(i1_ > 0 ? i1_ : 0); r2 = __int_as_float(i2_ > 0 ? i2_ : 0); r3 = __int_as_float(i3_ > 0 ? i3_ : 0); }
        float s = fmaf(w[0], r0, 0.0f); s = fmaf(w[1], r1, s); s = fmaf(w[2], r2, s); s = fmaf(w[3], r3, s);
        const int b = __float_as_int(s);
        u[t] = (unsigned)(b ^ ((b >> 31) | (int)0x80000000));
    }
}
#if defined(DSA_STAMP)
__device__ unsigned long long g_dsa_stamp = 0ull;
#define DSA_CLK() ((unsigned long long)__builtin_readcyclecounter())
#endif
constexpr unsigned CAND_CAP = 597u;
DEVI unsigned kbin(unsigned u) {
    const bool pos = (int)u < 0;
    const unsigned x = pos ? u : ~u;
    int m = (int)(x >> 19) - 5632; m = m < 0 ? 0 : m;
    const int mp = m > 1022 ? 1022 : m, mn = m > 1023 ? 1023 : m;
    return (u == 0x80000000u) ? 1024u : (pos ? (unsigned)(1025 + mp) : (unsigned)(1023 - mn));
}
struct PassState { unsigned prefix, T, need, cnt, eqc; unsigned mode; lds_u16* aux;
#if defined(DSA_STAMP)
    unsigned long long* pacc;
#endif
};
DEVI void lds_store2_masked(unsigned long long mask, unsigned addr_u, unsigned uval, unsigned addr_k, unsigned key) {
    unsigned long long sv;
    asm volatile("s_and_saveexec_b64 %0, %1\n\tds_write_b32 %2, %3\n\tds_write_b16 %4, %5\n\ts_mov_b64 exec, %0"
                 : "=&s"(sv) : "s"(mask), "v"(addr_u), "v"(uval), "v"(addr_k), "v"(key) : "memory", "scc");
}
template <bool ALLV>
DEVI void chunk_cand(const unsigned (&u)[4], int kc, int qpos, int g, int n16, lds_u32* cu, lds_u16* sel, PassState& st) {
    const unsigned below = (1u << n16) - 1u;
    const unsigned cub = (unsigned)(size_t)cu, ckb = (unsigned)(size_t)st.aux;
    unsigned long long mk[4];
#pragma unroll
    for (int t = 0; t < 4; ++t) {
        const int key = kc + t * 16 + n16;
        mk[t] = ALLV ? __builtin_amdgcn_uicmp(u[t], st.T, 35  ) : __builtin_amdgcn_ballot_w64(u[t] >= st.T && key <= qpos);
    }
    unsigned cnt = st.cnt;
#pragma unroll
    for (int t = 0; t < 4; ++t) {
        const int key = kc + t * 16 + n16;
        const unsigned mg = (unsigned)(mk[t] >> (16 * g));
        unsigned pc = cnt + (unsigned)__popc(mg & below);
        pc = pc < CAND_CAP - 1u ? pc : CAND_CAP - 1u;
        lds_store2_masked(mk[t], cub + 4u * pc, u[t], ckb + 2u * pc, (unsigned)key);
        cnt += (unsigned)__popc(mg & 0xffffu);
    }
    st.cnt = cnt;
    if (st.need) {
#pragma unroll
        for (int t = 0; t < 4; ++t) {
            const int key = kc + t * 16 + n16; const bool valid = ALLV ? true : (key <= qpos);
            const bool zdir = valid && st.mode && (u[t] == 0x80000000u);
            const unsigned mz = (unsigned)(__builtin_amdgcn_ballot_w64(zdir) >> (16 * g)) & 0xffffu;
            const unsigned pz = st.eqc + (unsigned)__popc(mz & below);
            if (zdir && pz < 256u) sel[pz] = (unsigned short)key;
            st.eqc += (unsigned)__popc(mz);
        }
    }
}
template <int PASS, bool ALLV>
DEVI void chunk_work(const unsigned (&u)[4], int kc, int qpos, int g, int n16, lds_u32* hist, lds_u16* sel, PassState& st) {
    if constexpr (PASS == 8) { chunk_cand<ALLV>(u, kc, qpos, g, n16, hist, sel, st); return; }
    const unsigned below = (1u << n16) - 1u;
#pragma unroll
    for (int t = 0; t < 4; ++t) {
        const int key = kc + t * 16 + n16; const bool valid = ALLV ? true : (key <= qpos);
        if (PASS == 7) { const unsigned bn = kbin(u[t]); __hip_atomic_fetch_add(hist + (bn >> 1), valid ? (1u << (16 * (bn & 1u))) : 0u, __ATOMIC_RELAXED, __HIP_MEMORY_SCOPE_WORKGROUP); }
        else if (PASS == 8) {
            const bool cand = valid && u[t] >= st.T;
            const unsigned long long mc64 = ALLV ? __builtin_amdgcn_uicmp(u[t], st.T, 35  ) : (__builtin_amdgcn_ballot_w64(u[t] >= st.T) & __builtin_amdgcn_ballot_w64(valid));
            const unsigned mc = (unsigned)(mc64 >> (16 * g)) & 0xffffu;
            const unsigned pc = st.cnt + (unsigned)__popc(mc & below);
            if (cand && pc < CAND_CAP) { hist[pc] = u[t]; st.aux[pc] = (unsigned short)key; }
            st.cnt += (unsigned)__popc(mc);
            if (st.need) {
                const bool zdir = valid && st.mode && (u[t] == 0x80000000u);
                const unsigned mz = (unsigned)(__builtin_amdgcn_ballot_w64(zdir) >> (16 * g)) & 0xffffu;
                const unsigned pz = st.eqc + (unsigned)__popc(mz & below);
                if (zdir && pz < 256u) sel[pz] = (unsigned short)key;
                st.eqc += (unsigned)__popc(mz);
            }
        }
        else if (PASS == 1) { const unsigned bn = u[t] >> 21; __hip_atomic_fetch_add(hist + (bn >> 1), valid ? (1u << (16 * (bn & 1u))) : 0u, __ATOMIC_RELAXED, __HIP_MEMORY_SCOPE_WORKGROUP); }
        else if (PASS == 2) { if (valid && (u[t] >> 21) == st.prefix) { const unsigned bn = (u[t] >> 10) & 0x7ffu; __hip_atomic_fetch_add(hist + (bn >> 1), 1u << (16 * (bn & 1u)), __ATOMIC_RELAXED, __HIP_MEMORY_SCOPE_WORKGROUP); } }
        else if (PASS == 3) { if (valid && (u[t] >> 10) == st.prefix) { const unsigned bn = u[t] & 0x3ffu; __hip_atomic_fetch_add(hist + (bn >> 1), 1u << (16 * (bn & 1u)), __ATOMIC_RELAXED, __HIP_MEMORY_SCOPE_WORKGROUP); } }
        else if (PASS == 4) {
            const bool take = valid && u[t] > st.T;
            const unsigned msel = (unsigned)((__builtin_amdgcn_ballot_w64(u[t] > st.T) & __builtin_amdgcn_ballot_w64(valid)) >> (16 * g)) & 0xffffu;
            const unsigned pos = st.cnt + (unsigned)__popc(msel & below);
            if (take && pos < 256u) sel[pos] = (unsigned short)key;
            st.cnt += (unsigned)__popc(msel);
        } else {
            const bool gt = valid && u[t] > st.T, eq = valid && u[t] == st.T;
            const unsigned meq = (unsigned)(__builtin_amdgcn_ballot_w64(eq) >> (16 * g)) & 0xffffu;
            const bool take = gt || (eq && (st.eqc + (unsigned)__popc(meq & below)) < st.need);
            const unsigned msel = (unsigned)(__builtin_amdgcn_ballot_w64(take) >> (16 * g)) & 0xffffu;
            const unsigned pos = st.cnt + (unsigned)__popc(msel & below);
            if (take && pos < 256u) sel[pos] = (unsigned short)key;
            st.cnt += (unsigned)__popc(msel); st.eqc += (unsigned)__popc(meq);
        }
    }
}
template <int PASS, int STRIDE>
DEVI void run_pass_blk(const bf16_t* IKb, int nst, int tid, int lane, const bf16x8& a0, const bf16x8& a1, const f32x4& w, int qpos, int qmaxw, lds_u32* hist, lds_u16* sel, PassState& st, lds_u8* stg) {
    const int g = lane >> 4, n16 = lane & 15;
    const int srow = tid >> 3, sch = tid & 7;
#if defined(DSA_STAMP)
    const bool stamp_on = (PASS == DSA_STAMP_PASS) && (blockIdx.x == DSA_STAMP_BLK) && (__builtin_amdgcn_readfirstlane(tid >> 6) == DSA_STAMP_WAVE);
    unsigned long long stacc = 0ull, stt = 0ull;
    if (DSA_STAMP == 2 && stamp_on) stt = DSA_CLK();
#endif
    const bf16_t* gp = IKb + (size_t)srow * 64 + sch * 8;
    const int woff = srow * 128 + ((sch ^ ((srow >> 1) & 7)) << 4);
    const int sw = (n16 >> 1) & 7;
    const int roff0 = n16 * 128 + ((g ^ sw) << 4), roff1 = n16 * 128 + (((g + 4) ^ sw) << 4);
#define DSA_LOAD(RA, RB, st_) do { const int s_ = ((st_) < nst) ? (st_) : nst - 1; const bf16_t* gn = gp + (size_t)s_ * (STRIDE * 128 * 64); RA = *(const u32x4*)gn; RB = *(const u32x4*)(gn + 64 * 64); } while (0)
#define DSA_WRITE(RA, RB, bufoff) do { *(__attribute__((address_space(3))) u32x4*)(stg + (bufoff) + woff) = RA; *(__attribute__((address_space(3))) u32x4*)(stg + (bufoff) + 8192 + woff) = RB; } while (0)
#if defined(DSA_STAMP)
#define DSA_STAMP3() do { if (DSA_STAMP == 3 && stamp_on) { asm volatile("s_waitcnt lgkmcnt(0)" ::: "memory"); stacc += DSA_CLK() - stt; } } while (0)
#else
#define DSA_STAMP3() do { } while (0)
#endif
#define DSA_COMPUTE(st_, bufoff) do { bf16x8 bfr[2][4][2];                   \
        _Pragma("unroll") for (int h = 0; h < 2; ++h) _Pragma("unroll") for (int t = 0; t < 4; ++t) { \
            bfr[h][t][0] = *(const __attribute__((address_space(3))) bf16x8*)(stg + (bufoff) + h * 8192 + t * 2048 + roff0); \
            bfr[h][t][1] = *(const __attribute__((address_space(3))) bf16x8*)(stg + (bufoff) + h * 8192 + t * 2048 + roff1); } \
        __builtin_amdgcn_sched_barrier(0); DSA_STAMP3(); \
        const int kc0_ = (st_) * (STRIDE * 128); \
        if ((PASS == 7 || PASS == 8) && kc0_ + 127 <= qmaxw - 3) {        \
            unsigned u0_[4], u1_[4]; chunk_scores(u0_, bfr[0], a0, a1, w); chunk_scores(u1_, bfr[1], a0, a1, w); \
            chunk_work<PASS, true>(u0_, kc0_, qpos, g, n16, hist, sel, st); chunk_work<PASS, true>(u1_, kc0_ + 64, qpos, g, n16, hist, sel, st); \
        } else { \
        _Pragma("unroll") for (int h = 0; h < 2; ++h) { const int kc = kc0_ + h * 64; if (kc <= qmaxw) { \
            unsigned u[4]; chunk_scores(u, bfr[h], a0, a1, w); \
            if ((PASS == 7 || PASS == 8) && kc + 63 <= qmaxw - 3) chunk_work<PASS, true>(u, kc, qpos, g, n16, hist, sel, st); else chunk_work<PASS, false>(u, kc, qpos, g, n16, hist, sel, st); } } } } while (0)
#if defined(DSA_STAMP)
#define DSA_BAR() do { asm volatile("s_waitcnt lgkmcnt(0)" ::: "memory"); unsigned long long tb_ = 0ull; if (DSA_STAMP == 1 && stamp_on) tb_ = DSA_CLK(); __builtin_amdgcn_s_barrier(); \
        if (DSA_STAMP == 1 && stamp_on) stacc += DSA_CLK() - tb_; if (DSA_STAMP == 3 && stamp_on) stt = DSA_CLK(); } while (0)
#else
#define DSA_BAR() do { asm volatile("s_waitcnt lgkmcnt(0)" ::: "memory"); __builtin_amdgcn_s_barrier(); } while (0)
#endif
    u32x4 p0, p1, q0r, q1r;
    DSA_LOAD(p0, p1, 0); DSA_WRITE(p0, p1, 0); DSA_LOAD(q0r, q1r, 1);
    DSA_BAR();
    for (int s = 0; s < nst; s += 2) {
        DSA_LOAD(p0, p1, s + 2);
        DSA_COMPUTE(s, 0);
        DSA_WRITE(q0r, q1r, STG_BYTES);
        DSA_BAR();
        {
            DSA_LOAD(q0r, q1r, s + 3);
            DSA_COMPUTE(s + 1, STG_BYTES);
            DSA_WRITE(p0, p1, 0);
            DSA_BAR();
        }
    }
#undef DSA_LOAD
#undef DSA_WRITE
#undef DSA_COMPUTE
#undef DSA_BAR
#undef DSA_STAMP3
#if defined(DSA_STAMP)
    if (DSA_STAMP == 2 && stamp_on) stacc = DSA_CLK() - stt;
    if (stamp_on && lane == 0) atomicAdd(st.pacc, stacc >> 4);
#endif
}
DEVI void scan_level(lds_u32* hist, int wpl, unsigned K, int lane, unsigned& bin, unsigned& Knew, unsigned& cbin, unsigned fracn = 0u) {
    const int i = lane & 15, g = lane >> 4;
    const lds_u32* hw = hist + i * wpl;
    const int spb = wpl >> 3;
    unsigned sb[8]; unsigned sum = 0u;
#pragma unroll
    for (int q = 0; q < 8; ++q) {
        unsigned s = 0u;
        for (int x = 0; x < spb; x += 4) { const u32x4 v = *(const __attribute__((address_space(3))) u32x4*)(hw + q * spb + x); s += (v.x & 0xffffu) + (v.x >> 16) + (v.y & 0xffffu) + (v.y >> 16) + (v.z & 0xffffu) + (v.z >> 16) + (v.w & 0xffffu) + (v.w >> 16); }
        sb[q] = s; sum += s;
    }
    unsigned suf = sum;
#pragma unroll
    for (int off = 1; off < 16; off <<= 1) { const unsigned t = (unsigned)bperm_i((int)suf, lane + off); if (i + off < 16) suf += t; }
    if (fracn) { const unsigned tot = (unsigned)bperm_i((int)suf, 16 * g); K = (tot * 380u + fracn - 1u) / fracn; K = K ? K : 1u; }
    const unsigned above = suf - sum;
    const bool found = (above < K && K <= suf);
    unsigned b = 0u, kn = 0u, cb = 0u;
    if (found) {
        unsigned cum = above; int qs = 0;
#pragma unroll
        for (int q = 7; q >= 0; --q) { if (qs == 0 && cum + sb[q] >= K) qs = q + 1; if (qs == 0) cum += sb[q]; }
        const int w0 = (qs - 1) * spb;
        for (int wi = w0 + spb - 1; wi >= w0; --wi) {
            const unsigned v = hw[wi]; const unsigned hi = v >> 16, lo = v & 0xffffu;
            if (cum + hi >= K) { b = (unsigned)(2 * (i * wpl + wi) + 1); kn = K - cum; cb = hi; break; }
            cum += hi;
            if (cum + lo >= K) { b = (unsigned)(2 * (i * wpl + wi)); kn = K - cum; cb = lo; break; }
            cum += lo;
        }
    }
    const unsigned gm = (unsigned)(__builtin_amdgcn_ballot_w64(found) >> (16 * g)) & 0xffffu;
    const int src = 16 * g + (gm ? __ffs((int)gm) - 1 : 0);
    bin = (unsigned)bperm_i((int)b, src); Knew = (unsigned)bperm_i((int)kn, src); cbin = (unsigned)bperm_i((int)cb, src);
}
DEVI void zero_hist(lds_u8* wl, int lane) {
    const u32x4 z = {0u, 0u, 0u, 0u};
#pragma unroll
    for (int x = 0; x < 16; ++x) *(__attribute__((address_space(3))) u32x4*)(wl + (x * 64 + lane) * 16) = z;
    asm volatile("s_waitcnt lgkmcnt(0)" ::: "memory");
}
DEVI bool block_any(bool flag, lds_u8* stg, int tid) {
    lds_u32* vw = (lds_u32*)stg;
    if (tid == 0) vw[0] = 0u;
    asm volatile("s_waitcnt lgkmcnt(0)" ::: "memory"); __builtin_amdgcn_s_barrier();
    if (flag && (tid & 63) == 0) vw[0] = 1u;
    asm volatile("s_waitcnt lgkmcnt(0)" ::: "memory"); __builtin_amdgcn_s_barrier();
    const bool r = vw[0] != 0u;
    asm volatile("s_waitcnt lgkmcnt(0)" ::: "memory"); __builtin_amdgcn_s_barrier();
    return r;
}

DEVI unsigned gsum16d(unsigned v) {
    v += (unsigned)__builtin_amdgcn_update_dpp(0, (int)v, 0xB1, 0xF, 0xF, true);
    v += (unsigned)__builtin_amdgcn_update_dpp(0, (int)v, 0x4E, 0xF, 0xF, true);
    v += (unsigned)__builtin_amdgcn_update_dpp(0, (int)v, 0x141, 0xF, 0xF, true);
    v += (unsigned)__builtin_amdgcn_update_dpp(0, (int)v, 0x140, 0xF, 0xF, true);
    return v;
}
DEVI unsigned gsum16(unsigned v, int lane) { v += (unsigned)bperm_i((int)v, lane ^ 1); v += (unsigned)bperm_i((int)v, lane ^ 2); v += (unsigned)bperm_i((int)v, lane ^ 4); v += (unsigned)bperm_i((int)v, lane ^ 8); return v; }
DEVI unsigned xpre16(unsigned v, int lane) {
    const int i = lane & 15; unsigned s = v;
#pragma unroll
    for (int off = 1; off < 16; off <<= 1) { const unsigned t = (unsigned)bperm_i((int)s, lane - off); if (i >= off) s += t; }
    return s - v;
}
DEVI void resolve_cands(const lds_u32* cu, const lds_u16* ck, unsigned c, lds_u16* sel, int lane) {
    const int i = lane & 15;
    const unsigned per = (c + 15u) >> 4;
    const unsigned j0 = (i * per < c) ? i * per : c, j1 = (j0 + per < c) ? j0 + per : c;
    unsigned cr[38];
#pragma unroll
    for (int x = 0; x < 38; ++x) cr[x] = (j0 + x < j1) ? cu[j0 + x] : 0u;
    unsigned prefix = 0u;
#pragma unroll 1
    for (int bit = 31; bit >= 0; --bit) {
        const unsigned trial = prefix | (1u << bit); unsigned cnt = 0u;
#pragma unroll
        for (int x = 0; x < 38; ++x) cnt += (cr[x] >= trial) ? 1u : 0u;
        if (gsum16d(cnt) >= 256u) prefix = trial;
    }
    const unsigned T = prefix;
    unsigned gtl = 0u, eql = 0u;
#pragma unroll
    for (int x = 0; x < 38; ++x) { gtl += (cr[x] > T) ? 1u : 0u; eql += (cr[x] == T && j0 + x < j1) ? 1u : 0u; }
    const unsigned need = 256u - gsum16d(gtl);
    const unsigned eqb = xpre16(eql, lane);
    const unsigned teq = (eqb >= need) ? 0u : ((need - eqb < eql) ? need - eqb : eql);
    unsigned pos = xpre16(gtl + teq, lane), eqs = 0u;
#pragma unroll
    for (int x = 0; x < 38; ++x) {
        const bool in = j0 + x < j1;
        const bool tk = in && (cr[x] > T || (cr[x] == T && eqs < teq));
        if (in && cr[x] == T) ++eqs;
        if (tk) { if (pos < 256u) sel[pos] = ck[j0 + x]; ++pos; }
    }
}
DEVI void group(int b, int q0, const bf16_t* IQ, const bf16_t* IK, const float* IW, const bf16_t* AQ_O, bf16_t* OUT_O, const bf16_t* AK, const bf16_t* AV, lds_u8* wl, lds_u8* stg, int Q0, int tid, int lane) {
    const int g = lane >> 4, n16 = lane & 15;
    const size_t m0 = (size_t)b * SEQ + q0;
    lds_u32* hist = (lds_u32*)wl + g * 1024;
    lds_u16* sel = (lds_u16*)(wl + OFF_SEL) + g * 256;
    const int qpos = q0 + g;
    if (Q0 + 31 < 256) {
        for (int k = n16; k < 256; k += 16) sel[k] = (unsigned short)k;
    } else {
        const bf16_t* IKb = IK + (size_t)b * SEQ * 64;
        bf16x8 a0, a1; f32x4 w;
        { const bf16_t* pq = IQ + (m0 + (n16 >> 2)) * 256 + (n16 & 3) * 64 + 8 * g; a0 = *(const bf16x8*)pq; a1 = *(const bf16x8*)(pq + 32); w = *(const f32x4*)(IW + (m0 + g) * 4); }
        const int nst = (Q0 + 32 + 127) >> 7;
        unsigned K = 256u, bin = 0u, cb = 0u;
        PassState st; st.prefix = 0u; st.T = 0u; st.need = 0u; st.cnt = 0u; st.eqc = 0u; st.mode = 0u; st.aux = nullptr;
#if defined(DSA_STAMP)
        st.pacc = (unsigned long long*)((char*)const_cast<bf16_t*>(IK) - WS_IK + WS_CTL + 24576);
#endif
        bool need_exact = true;
        {
            lds_u32* cu = (lds_u32*)(wl + g * 3584); lds_u16* ck = (lds_u16*)(wl + g * 3584 + 2388);
            if (Q0 + 32 > (int)CAND_CAP) {
                zero_hist(wl, lane);
                run_pass_blk<7, 2>(IKb, (nst + 1) >> 1, tid, lane, a0, a1, w, qpos, q0 + 3, hist, sel, st, stg);
                unsigned kd = 0u, cbd = 0u;
                scan_level(hist, 64, 96u, lane, bin, kd, cbd, (unsigned)(qpos + 1));
            } else bin = 0u;
            PassState ss; ss.prefix = bin; ss.cnt = 0u; ss.eqc = 0u; ss.mode = (bin == 1024u) ? 1u : 0u; ss.aux = ck;
#if defined(DSA_STAMP)
            ss.pacc = st.pacc;
#endif
            ss.T = (bin >= 1026u) ? ((4607u + bin) << 19) : (bin >= 1024u) ? 0x80000001u : (bin == 0u) ? 0u : ~(((6656u - bin) << 19) - 1u);
            ss.need = __any(ss.mode != 0u) ? 1u : 0u;
#if defined(DSA_DBL_P8)
            run_pass_blk<8, 1>(IKb, nst, tid, lane, a0, a1, w, qpos, q0 + 3, cu, sel, ss, stg); ss.cnt = 0u; ss.eqc = 0u;
#endif
            run_pass_blk<8, 1>(IKb, nst, tid, lane, a0, a1, w, qpos, q0 + 3, cu, sel, ss, stg);
            const unsigned c = ss.cnt, z = ss.eqc;
            const bool zfill = ss.mode && c < 256u;
            const bool bad = (c > CAND_CAP) || (zfill ? (c + z < 256u) : (c < 256u));
            need_exact = block_any(__any(bad), stg, tid);
#if defined(DSA_NOFALLBACK)
            need_exact = false;
#endif
            if (!need_exact) {
                if (zfill) { for (unsigned x = (unsigned)n16; x < c; x += 16u) sel[256u - c + x] = ck[x]; }
                else {
#if defined(DSA_DBL_RES)
                    resolve_cands(cu, ck, c, sel, lane);
#endif
                    resolve_cands(cu, ck, c, sel, lane); }
            }
        }
        if (need_exact) {
#if defined(DSA_DBL_P1)
        zero_hist(wl, lane);
        run_pass_blk<1, 1>(IKb, nst, tid, lane, a0, a1, w, qpos, q0 + 3, hist, sel, st, stg);
#endif
        zero_hist(wl, lane);
        run_pass_blk<1, 1>(IKb, nst, tid, lane, a0, a1, w, qpos, q0 + 3, hist, sel, st, stg);
        scan_level(hist, 64, K, lane, bin, K, cb); st.prefix = bin;
#if defined(DSA_DBL_P2)
        zero_hist(wl, lane);
        run_pass_blk<2, 1>(IKb, nst, tid, lane, a0, a1, w, qpos, q0 + 3, hist, sel, st, stg);
#endif
        zero_hist(wl, lane);
        run_pass_blk<2, 1>(IKb, nst, tid, lane, a0, a1, w, qpos, q0 + 3, hist, sel, st, stg);
        scan_level(hist, 64, K, lane, bin, K, cb);
        const unsigned p22 = (st.prefix << 11) | bin;
        const bool done2 = (cb == K) && (p22 != 0u);
        if (done2) { st.T = (p22 << 10) - 1u; st.need = 0u; st.prefix = 0xffffffffu; } else { st.prefix = p22; }
        if (block_any(__any(!done2), stg, tid)) {
            zero_hist(wl, lane);
            run_pass_blk<3, 1>(IKb, nst, tid, lane, a0, a1, w, qpos, q0 + 3, hist, sel, st, stg);
            if (!done2) {
                scan_level(hist, 32, K, lane, bin, K, cb);
                st.T = (p22 << 10) | bin; st.need = K;
                if (cb == K && st.T != 0u) { st.T -= 1u; st.need = 0u; }
            }
        }
        if (block_any(__any(st.need != 0u), stg, tid)) run_pass_blk<5, 1>(IKb, nst, tid, lane, a0, a1, w, qpos, q0 + 3, hist, sel, st, stg);
        else run_pass_blk<4, 1>(IKb, nst, tid, lane, a0, a1, w, qpos, q0 + 3, hist, sel, st, stg);
        }
    }
    asm volatile("s_waitcnt lgkmcnt(0)" ::: "memory");
    const bf16_t* AKb = AK + (size_t)b * SEQ * 64; const bf16_t* AVb = AV + (size_t)b * SEQ * 64;
    const lds_u16* selw = (const lds_u16*)(wl + OFF_SEL);
#if defined(DSA_DBL_ATT)
#define DSA_NJ 8
#else
#define DSA_NJ 4
#endif
#pragma unroll 1
    for (int jl = 0; jl < DSA_NJ; ++jl) {
        int j = jl & 3; asm volatile("" : "+s"(j));
        const int qp = q0 + j; const int cntj = (qp + 1 < 256) ? qp + 1 : 256;
        const lds_u16* sj = selw + j * 256;
        bf16x8 qf0 = {0, 0, 0, 0, 0, 0, 0, 0}, qf1 = qf0;
        if (n16 < 8) { const bf16_t* pq = AQ_O + (m0 + j) * 512 + n16 * 64 + 8 * g; qf0 = *(const bf16x8*)pq; qf1 = *(const bf16x8*)(pq + 32); }
        u32x4 vr[2][8];
#define DSA_VLOAD(c_, buf_) do { _Pragma("unroll") for (int e = 0; e < 8; ++e) { const int pos_ = 64 * (c_) + e * 8 + (lane >> 3); const int key_ = (pos_ < cntj) ? (int)sj[pos_] : 0; \
            vr[buf_][e] = *(const u32x4*)(AVb + (size_t)key_ * 64 + (lane & 7) * 8); } } while (0)
        DSA_VLOAD(0, 0);
        f32x4 sc[16];
#pragma unroll
        for (int hf = 0; hf < 2; ++hf) {
            bf16x8 kf[8][2];
#pragma unroll
            for (int t = 0; t < 8; ++t) {
                const int pos = 16 * (8 * hf + t) + n16; const int key = (pos < cntj) ? (int)sj[pos] : 0;
                const bf16_t* pk = AKb + (size_t)key * 64 + 8 * g;
                kf[t][0] = *(const bf16x8*)pk; kf[t][1] = *(const bf16x8*)(pk + 32);
            }
#pragma unroll
            for (int t = 0; t < 8; ++t) {
                f32x4 c = {0.f, 0.f, 0.f, 0.f};
                c = __builtin_amdgcn_mfma_f32_16x16x32_bf16(kf[t][0], qf0, c, 0, 0, 0);
                c = __builtin_amdgcn_mfma_f32_16x16x32_bf16(kf[t][1], qf1, c, 0, 0, 0);
                sc[8 * hf + t] = c;
            }
        }
        float mx = -INFINITY;
#pragma unroll
        for (int t = 0; t < 16; ++t)
#pragma unroll
            for (int r = 0; r < 4; ++r) { if (16 * t + 4 * g + r >= cntj) sc[t][r] = -INFINITY; mx = fmaxf(mx, sc[t][r]); }
        mx = fmaxf(mx, bperm_xor(mx, lane, 16)); mx = fmaxf(mx, bperm_xor(mx, lane, 32));
        float sum = 0.f;
#pragma unroll
        for (int t = 0; t < 16; ++t)
#pragma unroll
            for (int r = 0; r < 4; ++r) { sc[t][r] = __builtin_amdgcn_exp2f(sc[t][r] - mx); sum += sc[t][r]; }
        sum += bperm_xor(sum, lane, 16); sum += bperm_xor(sum, lane, 32);
        const float inv = 1.0f / sum;
        unsigned pkp[16][2];
#pragma unroll
        for (int t = 0; t < 16; ++t) { pkp[t][0] = pk2(sc[t][0] * inv, sc[t][1] * inv); pkp[t][1] = pk2(sc[t][2] * inv, sc[t][3] * inv); }
        f32x4 o[4];
#pragma unroll
        for (int d = 0; d < 4; ++d) o[d] = (f32x4){0.f, 0.f, 0.f, 0.f};
#pragma unroll
        for (int c = 0; c < 4; ++c) {
            asm volatile("s_waitcnt lgkmcnt(0)" ::: "memory");
#pragma unroll
            for (int e = 0; e < 8; ++e) *(__attribute__((address_space(3))) u32x4*)(wl + (e * 8 + (lane >> 3)) * VROW + (lane & 7) * 16) = vr[c & 1][e];
            if (c < 3) DSA_VLOAD(c + 1, (c + 1) & 1);
            asm volatile("s_waitcnt lgkmcnt(0)" ::: "memory");
#pragma unroll
            for (int ks = 0; ks < 2; ++ks) {
                const int t0 = 4 * c + 2 * ks;
                bf16x8 pa; { u32x4 t4 = {pkp[t0][0], pkp[t0][1], pkp[t0 + 1][0], pkp[t0 + 1][1]}; pa = __builtin_bit_cast(bf16x8, t4); }
                const lds_u8* vb = wl + (32 * ks + 4 * g + (n16 >> 2)) * VROW + (n16 & 3) * 8;
#pragma unroll
                for (int d = 0; d < 4; ++d) {
                    const s16x4 lo = __builtin_bit_cast(s16x4, __builtin_amdgcn_ds_read_tr16_b64_v4i16((__attribute__((address_space(3))) s16x4*)(vb + d * 32)));
                    const s16x4 hi = __builtin_bit_cast(s16x4, __builtin_amdgcn_ds_read_tr16_b64_v4i16((__attribute__((address_space(3))) s16x4*)(vb + 16 * VROW + d * 32)));
                    const bf16x8 vf = {lo[0], lo[1], lo[2], lo[3], hi[0], hi[1], hi[2], hi[3]};
                    o[d] = __builtin_amdgcn_mfma_f32_16x16x32_bf16(pa, vf, o[d], 0, 0, 0);
                }
            }
        }
#undef DSA_VLOAD
        if (g < 2) {
            bf16_t* po = ((DSA_NJ == 8 && jl < 4) ? OUT_O + ((size_t)104 << 19) : OUT_O) + (m0 + j) * 512;
#pragma unroll
            for (int d = 0; d < 4; ++d)
#pragma unroll
                for (int r = 0; r < 4; ++r) po[(4 * g + r) * 64 + 16 * d + n16] = (bf16_t)(pk2(o[d][r], 0.f) & 0xffffu);
        }
    }
    asm volatile("s_waitcnt lgkmcnt(0)" ::: "memory");
}
}

#ifndef MK_DSA
#define MK_DSA 1
#endif
#ifndef MK_DBL
#define MK_DBL 0
#endif
enum { DBL_DSA = 0x200, DBL_SWA = 0x400 };
constexpr size_t WS_DUMMY = 176 * MiB;
struct MKArgs { const float* in[10]; float* out; unsigned char* ws; int l_lo, l_hi, pmask, fin; };
constexpr int MK_LDS = dsa::DSA_LDS;
#ifndef MK_EN
#define MK_EN 0x1ff
#endif
enum { PH_PREP = 1, PH_P1 = 2, PH_ATT1 = 4, PH_ATT2 = 8, PH_GATE = 16, PH_BRANCH = 32, PH_OUT = 64, PH_FF1 = 128, PH_FF2 = 256 };

#ifndef MK_WQ
#define MK_WQ 1
#endif
#ifndef MK_GROUPS
#define MK_GROUPS 1
#endif
#ifndef MK_POOL_GATE
#define MK_POOL_GATE 1
#endif
constexpr int P1_TILES = (M / 256) * (NPERM / 256), GATE_TILES = (M / 256) * (3072 / 256);
struct OneTile {
    int pm, pn;
    __device__ bool next(int i, pg8::Unit& u) const { if (i != 0) return false; u.pm = pm; u.pn = pn; u.ord = 0; return true; }
    DEVI void a_ready(const pg8::Unit&) const {}
    DEVI void done(const pg8::Unit&) const {}
};
struct GSched {
    pg8::StaticOrder S; int gm, pm, pn0, n;
    __device__ bool next(int i, pg8::Unit& u) const { if (!gm) return S.next(i, u); if (i >= n) return false; u.pm = pm; u.pn = pn0 + i; u.ord = i; return true; }
    DEVI void a_ready(const pg8::Unit&) const {}
    DEVI void done(const pg8::Unit&) const {}
};
constexpr size_t CTL_GRP = 20480;
constexpr int GRP_LDS = 139280;
#define MK_GRP_LOAD() const int gm_ = __builtin_amdgcn_readfirstlane(((LAS int*)(lds + GRP_LDS))[0]), gpm_ = __builtin_amdgcn_readfirstlane(((LAS int*)(lds + GRP_LDS))[1]), gj_ = __builtin_amdgcn_readfirstlane(((LAS int*)(lds + GRP_LDS))[2])
#define MK_GRP_SYNC(bi_) do { if (gm_) { KARGS(kg_); const int n_ = __builtin_amdgcn_readfirstlane(((LAS int*)(lds + GRP_LDS))[3]) + 1; \
        group_sync((unsigned*)(kg_->ws + WS_CTL), (unsigned*)(kg_->ws + WS_CTL + CTL_GRP) + 16 * gpm_, 4u * (unsigned)n_, MK_TID() == 0); if (MK_TID() == 0) ((LAS int*)(lds + GRP_LDS))[3] = n_; __syncthreads(); } else GRID_SYNC_I(bi_); } while (0)
constexpr int TR_I_IN = 16 * (NPERM / 32), TR_I_GATE = 16 * (3072 / 32), TR_I_BR = 8 * 32, TR_I_OUT = 16 * 32, TR_I_FF1 = 16 * 128, TR_I_FF2 = 64 * 32;
DEVI TrItem tr_decode(int it, int lane, const float* w_in, const float* w_br, const float* w_out, const float* w_ff1, const float* w_ff2, unsigned char* ws) {
    TrItem t; int r = it, kb, nb;
    if (r < TR_I_IN) { kb = r / (NPERM / 32); nb = r % (NPERM / 32); t.W = w_in; t.ldw = NIN; t.K = 1024; t.WT = (bf16_t*)(ws + WS_W + WO_IN); t.sc = win_src_col(32 * nb + (lane & 31)); }
    else if ((r -= TR_I_IN) < TR_I_GATE) { kb = r / 96; nb = r % 96; t.W = w_in; t.ldw = NIN; t.K = 1024; t.WT = (bf16_t*)(ws + WS_W + WO_GATE); t.sc = NPROJ + 32 * nb + (lane & 31); }
    else if ((r -= TR_I_GATE) < 3 * TR_I_BR) { const int br = r / TR_I_BR, q = r % TR_I_BR; kb = q / 32; nb = q % 32; t.W = w_br + (size_t)br * 512 * 1024; t.ldw = 1024; t.K = 512; t.WT = (bf16_t*)(ws + WS_W + WO_BR) + (size_t)br * 1024 * 512; t.sc = 32 * nb + (lane & 31); }
    else if ((r -= 3 * TR_I_BR) < TR_I_OUT) { kb = r / 32; nb = r % 32; t.W = w_out; t.ldw = 1024; t.K = 1024; t.WT = (bf16_t*)(ws + WS_W + WO_OUT); t.sc = 32 * nb + (lane & 31); }
    else if ((r -= TR_I_OUT) < TR_I_FF1) { kb = r / 128; nb = r % 128; t.W = w_ff1; t.ldw = DFF; t.K = 1024; t.WT = (bf16_t*)(ws + WS_W + WO_FF1); t.sc = 32 * nb + (lane & 31); }
    else { r -= TR_I_FF1; kb = r / 32; nb = r % 32; t.W = w_ff2; t.ldw = 1024; t.K = DFF; t.WT = (bf16_t*)(ws + WS_W + WO_FF2); t.sc = 32 * nb + (lane & 31); }
    t.k0 = 64 * kb; t.n0 = 32 * nb; return t;
}
typedef const __attribute__((address_space(4))) MKArgs* kargs_t;
#define KARGS(ka) kargs_t ka = (kargs_t)__builtin_amdgcn_kernarg_segment_ptr(); asm volatile("" : "+s"(ka))

__global__ void __launch_bounds__(512, 2) mk_fwd(MKArgs a_unused) {
    extern __shared__ __attribute__((aligned(16))) unsigned char lds_raw[];
    const int wave_s = __builtin_amdgcn_readfirstlane((int)threadIdx.x >> 6);
#define MK_TID() (wave_s * 64 + mk_lane_id())
    LAS unsigned char* lds = (LAS unsigned char*)lds_raw;
#if defined(MK_STAMP_SYNC)
#define GRID_SYNC_I(bi_) do { KARGS(kb_); const bool pr_ = (blockIdx.x == MK_STAMP_SYNC_BLK) && (MK_TID() == 0) && (((MK_STAMP_SYNC_MASK) >> bi_) & 1); unsigned long long ts0_ = 0; if (pr_) ts0_ = __builtin_amdgcn_s_memrealtime(); \
    xcd_barrier((unsigned*)(kb_->ws + WS_CTL), MK_TID() == 0); if (pr_) atomicAdd((unsigned long long*)(kb_->ws + WS_CTL + 24576), __builtin_amdgcn_s_memrealtime() - ts0_); } while (0)
#define GRID_SYNC() GRID_SYNC_I(31)
#else
#define GRID_SYNC() do { KARGS(kb_); xcd_barrier((unsigned*)(kb_->ws + WS_CTL), MK_TID() == 0); } while (0)
#define GRID_SYNC_I(bi_) GRID_SYNC()
#endif
#define PHASE_IDS() int tid = MK_TID(); asm volatile("" : "+v"(tid)); const int lane = tid & 63, wave = __builtin_amdgcn_readfirstlane(tid >> 6); (void)lane; (void)wave
    int l_lo, l_hi, pmask;
    { KARGS(ka); l_lo = ka->l_lo; l_hi = ka->l_hi; pmask = ka->pmask; }
    { KARGS(ka); if (MK_TID() == 0) { const unsigned r_ = xb_add((unsigned*)(ka->ws + WS_CTL) + XB_XCNT(xb_xcc_id()), 1u);
        ((unsigned*)(ka->ws + WS_CTL + 19456))[blockIdx.x] = r_; }
      if (ka->pmask == 0x7fffffff) cg::this_grid().sync(); }

#if defined(MK_XSYNC)
    for (int xs = 0; xs < MK_XSYNC; ++xs) GRID_SYNC();
#endif
    bool fin_done = false;
    for (int l = l_lo; l < l_hi; ++l) {
        for (int rep_ = 0; rep_ < ((MK_DBL & PH_PREP) ? 2 : 1); ++rep_)
        if ((MK_EN & PH_PREP) && (pmask & PH_PREP)) {
            KARGS(ka); unsigned char* ws = ka->ws; PHASE_IDS();
            const int G = gridDim.x, gw = blockIdx.x * 8 + wave, NGW = G * 8;
            LAS float* scr = (LAS float*)(lds + wave * 16384);
            const float* w_in = ka->in[2] + (size_t)l * DMODEL * NIN;
            const float* w_br = ka->in[4] + (size_t)l * 3 * 512 * 1024;
            const float* w_out = ka->in[5] + (size_t)l * 1024 * 1024;
            const float* w_ff1 = ka->in[7] + (size_t)l * DMODEL * DFF;
            const float* w_ff2 = ka->in[8] + (size_t)l * DFF * DMODEL;
            bf16_t* WIN = (bf16_t*)(ws + WS_W + WO_IN); bf16_t* WGATE = (bf16_t*)(ws + WS_W + WO_GATE); bf16_t* WBR = (bf16_t*)(ws + WS_W + WO_BR);
            bf16_t* WOUT = (bf16_t*)(ws + WS_W + WO_OUT); bf16_t* WFF1 = (bf16_t*)(ws + WS_W + WO_FF1); bf16_t* WFF2 = (bf16_t*)(ws + WS_W + WO_FF2);
            constexpr int I_IN = 16 * (NPERM / 32), I_GATE = 16 * (3072 / 32), I_BR = 8 * 32, I_OUT = 16 * 32, I_FF1 = 16 * 128, I_FF2 = 64 * 32;
            constexpr int NITEMS = MK_WQ ? I_IN + I_GATE : I_IN + I_GATE + 3 * I_BR + I_OUT + I_FF1 + I_FF2;
            {
                float va[32], vb[32];
                int it0 = gw;
                tr_load(tr_decode(it0 < NITEMS ? it0 : NITEMS - 1, lane, w_in, w_br, w_out, w_ff1, w_ff2, ws), va, lane);
                for (; it0 < NITEMS; it0 += 2 * NGW) {
                    const int it1 = it0 + NGW, it2 = it0 + 2 * NGW;
                    tr_load(tr_decode(it1 < NITEMS ? it1 : NITEMS - 1, lane, w_in, w_br, w_out, w_ff1, w_ff2, ws), vb, lane);
                    tr_store(tr_decode(it0, lane, w_in, w_br, w_out, w_ff1, w_ff2, ws), va, scr, lane);
                    tr_load(tr_decode(it2 < NITEMS ? it2 : NITEMS - 1, lane, w_in, w_br, w_out, w_ff1, w_ff2, ws), va, lane);
                    if (it1 < NITEMS) tr_store(tr_decode(it1, lane, w_in, w_br, w_out, w_ff1, w_ff2, ws), vb, scr, lane);
                }
            }
            { float* KMz = (float*)(ws + WS_KMEAN); for (int i = blockIdx.x * 512 + tid; i < 2 * 8 * 32 * 64; i += G * 512) KMz[i] = 0.f; }
            if (l == 0) {
                float* COS = (float*)(ws + WS_COS); float* SIN = (float*)(ws + WS_SIN);
                float* SSQ = (float*)(ws + WS_SSQ); bf16_t* XG = (bf16_t*)(ws + WS_XG);
                for (int i = blockIdx.x * 512 + tid; i < SEQ * 32; i += G * 512) sincos_tab(i, COS, SIN);
                const float* g1 = ka->in[1]; const float* x = ka->in[0];
                const float4* gr = (const float4*)g1;
                float4 gg[4];
#pragma unroll
                for (int j = 0; j < 4; ++j) gg[j] = gr[lane + 64 * j];
                for (int m0 = gw; m0 < M; m0 += 4 * NGW) {
                    float4 v[4][4];
#pragma unroll
                    for (int r = 0; r < 4; ++r) { const int m = (m0 + r * NGW < M) ? m0 + r * NGW : m0; const float4* xr = (const float4*)(x + (size_t)m * DMODEL);
#pragma unroll
                        for (int j = 0; j < 4; ++j) v[r][j] = xr[lane + 64 * j]; }
#pragma unroll
                    for (int r = 0; r < 4; ++r) { const int m = m0 + r * NGW; if (m < M) {
                        float s = 0.f;
#pragma unroll
                        for (int j = 0; j < 4; ++j) {
                            const float4 w = v[r][j];
                            s += (w.x * w.x + w.y * w.y) + (w.z * w.z + w.w * w.w);
                            u32x2 o; o.x = pk2(w.x * gg[j].x, w.y * gg[j].y); o.y = pk2(w.z * gg[j].z, w.w * gg[j].w);
                            *(u32x2*)(XG + (size_t)m * DMODEL + 4 * (lane + 64 * j)) = o;
                        }
                        s = wave_sum_l(s, lane);
                        if (lane < 16) SSQ[(size_t)m * 16 + lane] = (lane == 0) ? s : 0.f;
                    } }
                }
            }
            GRID_SYNC_I(0);
        }
        for (int rep_ = 0; rep_ < ((MK_DBL & PH_P1) ? 2 : 1); ++rep_)
        if ((MK_EN & PH_P1) && (pmask & PH_P1)) {
            KARGS(ka); unsigned char* ws = ka->ws;
            pg8::Gemm g{(const bf16_t*)(ws + WS_XG), (const bf16_t*)(ws + WS_W + WO_IN), M, NPERM, DMODEL}; pg8::StaticOrder S; S.init(M, NPERM, (int)gridDim.x, (int)blockIdx.x);
            fill_rstd_table(S, (const float*)(ws + WS_SSQ), lds, MK_TID());
            EpiProjMK E{(const LAS float*)(lds + RSTD_TAB_OFF), ws, (const float*)(ws + WS_COS), (const float*)(ws + WS_SIN)};
            pg8::gemm_phase<EpiProjMK, pg8::StaticOrder, true, true>(lds, g, S, E, MK_TID());
        }
        if ((MK_EN & PH_P1) && (pmask & PH_P1)) {
            KARGS(ka); unsigned char* ws = ka->ws;
            const int rem = MK_POOL_GATE ? P1_TILES % (int)gridDim.x : 0;
            if (rem != 0 && (int)blockIdx.x >= rem && (int)blockIdx.x - rem < GATE_TILES) {
                const int gt = (int)blockIdx.x - rem;
                pg8::Gemm g{(const bf16_t*)(ws + WS_XG), (const bf16_t*)(ws + WS_W + WO_GATE), M, 3072, DMODEL}; OneTile S{gt & 63, gt >> 6};
                fill_rstd_table(S, (const float*)(ws + WS_SSQ), lds, MK_TID());
                EpiActMK<0> E{(const LAS float*)(lds + RSTD_TAB_OFF), (void*)(ws + WS_GS), 3072};
                pg8::gemm_phase<EpiActMK<0>, OneTile, true, true>(lds, g, S, E, MK_TID());
            }
            GRID_SYNC_I(1);
        }
        if ((MK_EN & PH_ATT1) && (pmask & PH_ATT1)) {
            KARGS(ka); unsigned char* ws = ka->ws; PHASE_IDS();
            const int G = gridDim.x, gw = blockIdx.x * 8 + wave, NGW = G * 8;
#if MK_DSA
            {
                const bf16_t* IQ = (const bf16_t*)(ws + WS_IQ); const bf16_t* IK = (const bf16_t*)(ws + WS_IK); const float* IW = (const float*)(ws + WS_IW);
                bf16_t* AQ = (bf16_t*)(ws + WS_AQ); const bf16_t* AK = (const bf16_t*)(ws + WS_AK); const bf16_t* AV = (const bf16_t*)(ws + WS_AV);
                dsa::lds_u8* wl = (dsa::lds_u8*)lds + wave * dsa::WAVE_LDS;
                dsa::lds_u8* stg = (dsa::lds_u8*)lds + dsa::OFF_STG;
#pragma unroll 1
                for (int i2 = 2 * (int)blockIdx.x; i2 < 512; i2 += 2 * G) {
#pragma unroll 1
                    for (int k = 0; k < ((MK_DBL & DBL_DSA) ? 4 : 2); ++k) {
                        int bb = (i2 >> 1) & 1, QQ = (k & 1) ? 32 * (255 - (i2 >> 2)) : 32 * (i2 >> 2);
                        asm volatile("" : "+s"(bb), "+s"(QQ));
                        bf16_t* OO = ((MK_DBL & DBL_DSA) && k < 2) ? (bf16_t*)(ws + WS_DUMMY) : AQ;
                        dsa::group(bb, QQ + 4 * wave, IQ, IK, IW, AQ, OO, AK, AV, wl, stg, QQ, tid, lane);
                    }
                }
                __syncthreads();
            }
#endif
            {
                const int x = (int)blockIdx.x & 7;
                const int rem = MK_POOL_GATE ? P1_TILES % (int)gridDim.x : 0, ngs = rem ? (((int)gridDim.x - rem) < GATE_TILES ? ((int)gridDim.x - rem) : GATE_TILES) : 0;
                const int ngx = MK_POOL_GATE ? (GATE_TILES - ngs - x + 7) >> 3 : 0;
                constexpr int WQ_FIRST = TR_I_IN + TR_I_GATE, WQ_ITEMS = 3 * TR_I_BR + TR_I_OUT + TR_I_FF1 + TR_I_FF2, WQ_CH = 32;
                static_assert(WQ_ITEMS % (8 * WQ_CH) == 0, "chunks split evenly over the 8 queues");
                const int nwq = MK_WQ ? WQ_ITEMS / (8 * WQ_CH) : 0;
                const int total = 64 + ngx + 64 + nwq;
                unsigned* qc = (unsigned*)(ws + WS_CTL + 28672) + (l * 8 + x) * 16;
                LAS unsigned* slot = (LAS unsigned*)(lds + 139264);
                const attn_body::bf16* BQ = (const attn_body::bf16*)(ws + WS_BQ); const attn_body::bf16* BK = (const attn_body::bf16*)(ws + WS_BK); const attn_body::bf16* BV = (const attn_body::bf16*)(ws + WS_BV);
                const attn_body::bf16* CQ = (const attn_body::bf16*)(ws + WS_CQ); const attn_body::bf16* CK = (const attn_body::bf16*)(ws + WS_CK); const attn_body::bf16* CV = (const attn_body::bf16*)(ws + WS_CV);
                if (MK_TID() == 0) slot[0] = atomicAdd(qc, 1u);
                __syncthreads();
                int cur = __builtin_amdgcn_readfirstlane((int)slot[0]);
#pragma unroll 1
                while (cur < total) {
                    unsigned nxt = 0u;
                    const bool pre = cur >= 64;
                    if (pre && MK_TID() == 0) nxt = atomicAdd(qc, 1u);
                    if (cur < 64) {
                        const int qb = 31 - (cur >> 1), bh = 2 * x + (cur & 1), h = bh & 7, b = bh >> 3;
                        LAS float* kml = (LAS float*)(lds + 98304);
                        { const int t_ = MK_TID(); *(LAS f32x4*)(kml + 4 * t_) = *(const f32x4*)((const float*)(ws + WS_KMEAN) + (size_t)bh * 2048 + 4 * t_); asm volatile("s_waitcnt vmcnt(0) lgkmcnt(0)" ::: "memory"); __builtin_amdgcn_s_barrier(); }
                        attn_body::attn_unit<8, 0, 512, 512>(b, qb, h * 64, h * 64, CQ, CK, CV, (attn_body::bf16*)(ws + WS_CQ), (const LAS float*)kml, 0.f, (char*)lds_raw, MK_TID());
                    } else if (cur < 64 + ngx) {
                        const int gt = ngs + x + 8 * (cur - 64);
                        pg8::Gemm g{(const bf16_t*)(ws + WS_XG), (const bf16_t*)(ws + WS_W + WO_GATE), M, 3072, DMODEL}; OneTile S{gt & 63, gt >> 6};
                        fill_rstd_table(S, (const float*)(ws + WS_SSQ), lds, MK_TID());
                        EpiActMK<0> E{(const LAS float*)(lds + RSTD_TAB_OFF), (void*)(ws + WS_GS), 3072};
                        pg8::gemm_phase<EpiActMK<0>, OneTile, true, true>(lds, g, S, E, MK_TID());
                    } else if (cur >= 64 + ngx + 64) {
                        const int it_b = WQ_FIRST + WQ_CH * (x + 8 * (cur - 64 - ngx - 64));
                        const float* w_in = ka->in[2] + (size_t)l * DMODEL * NIN; const float* w_br = ka->in[4] + (size_t)l * 3 * 512 * 1024; const float* w_out = ka->in[5] + (size_t)l * 1024 * 1024;
                        const float* w_ff1 = ka->in[7] + (size_t)l * DMODEL * DFF; const float* w_ff2 = ka->in[8] + (size_t)l * DFF * DMODEL;
                        LAS float* scr = (LAS float*)(lds + wave * 16384);
                        int ln_ = mk_lane_id(); asm volatile("" : "+v"(ln_));
#pragma unroll 1
                        for (int it0 = it_b + wave; it0 < it_b + WQ_CH; it0 += 8) {
                            float va[32];
                            const TrItem t = tr_decode(it0, ln_, w_in, w_br, w_out, w_ff1, w_ff2, ws);
                            tr_load(t, va, ln_); tr_store(t, va, scr, ln_);
                        }
                    } else {
                        const int i = 64 * x + (cur - 64 - ngx);
                        const int qb = i & 31, bh = i >> 5, h = bh & 7, b = bh >> 3;
                        const float* sinks = ka->in[3] + l * 8;
                        attn_body::attn_unit<8, 1, 512, 128>(b, qb, h * 64, (h >> 2) * 64, BQ, BK, BV, (attn_body::bf16*)(ws + WS_BQ), (const LAS float*)nullptr, sinks[h] * LOG2E, (char*)lds_raw, MK_TID());
                    }
                    __syncthreads();
                    if (MK_TID() == 0) { if (!pre) nxt = atomicAdd(qc, 1u); slot[0] = nxt; }
                    __syncthreads();
                    cur = __builtin_amdgcn_readfirstlane((int)slot[0]);
                }
            }
#if defined(MK_ARRIVE_PROBE)
            if (MK_TID() == 0 && l == MK_ARRIVE_L) ((unsigned long long*)(ws + WS_CTL + 24576 + 64))[blockIdx.x] = __builtin_amdgcn_s_memrealtime();
#endif
            GRID_SYNC_I(3);
#if defined(MK_ARRIVE_PROBE)
            if (blockIdx.x == 0 && MK_TID() == 0 && l == MK_ARRIVE_L) {
                const unsigned long long* arr = (const unsigned long long*)(ws + WS_CTL + 24576 + 64);
                unsigned long long mx = 0ull, mn = ~0ull; int am = 0;
                for (int i = 0; i < (int)gridDim.x; ++i) { const unsigned long long t = __hip_atomic_load(arr + i, __ATOMIC_RELAXED, __HIP_MEMORY_SCOPE_AGENT); if (t > mx) { mx = t; am = i; } if (t < mn) mn = t; }
                int cnt = 0;
                for (int i = 0; i < (int)gridDim.x; ++i) { const unsigned long long t = __hip_atomic_load(arr + i, __ATOMIC_RELAXED, __HIP_MEMORY_SCOPE_AGENT); if (t + MK_ARRIVE_WIN >= mx) ++cnt; }
                const unsigned long long R = (MK_ARRIVE_PROBE == 1) ? (unsigned long long)am * 400ull : (MK_ARRIVE_PROBE == 2) ? (unsigned long long)cnt * 400ull : (mx - mn);
                __hip_atomic_store((unsigned long long*)(ws + WS_CTL + 24576), R, __ATOMIC_RELAXED, __HIP_MEMORY_SCOPE_AGENT);
            }
#endif
        }
#if !MK_POOL_GATE
        for (int rep_ = 0; rep_ < ((MK_DBL & PH_GATE) ? 2 : 1); ++rep_)
        if ((MK_EN & PH_GATE) && (pmask & PH_GATE)) {
            KARGS(ka); unsigned char* ws = ka->ws;
            pg8::Gemm g{(const bf16_t*)(ws + WS_XG), (const bf16_t*)(ws + WS_W + WO_GATE), M, 3072, DMODEL}; pg8::StaticOrder S; S.init(M, 3072, (int)gridDim.x, (int)blockIdx.x);
            fill_rstd_table(S, (const float*)(ws + WS_SSQ), lds, MK_TID());
            EpiActMK<0> E{(const LAS float*)(lds + RSTD_TAB_OFF), (void*)(ws + WS_GS), 3072};
            pg8::gemm_phase<EpiActMK<0>, pg8::StaticOrder, true, true>(lds, g, S, E, MK_TID());
            GRID_SYNC_I(4);
        }
#endif
        for (int rep_ = 0; rep_ < ((MK_DBL & PH_BRANCH) ? 2 : 1); ++rep_)
        if ((MK_EN & PH_BRANCH) && (pmask & PH_BRANCH)) {
            {
                KARGS(ka); unsigned char* ws = ka->ws;
                static_assert(WS_BQ - WS_AQ == (size_t)M * 512 * 2 && WS_CQ - WS_BQ == (size_t)M * 512 * 2, "O_a | O_b | O_c contiguous");
                {
                    const unsigned* bar = (const unsigned*)(ws + WS_CTL); bool ok = MK_GROUPS && (int)gridDim.x == 256;
#pragma unroll 1
                    for (int jx = 0; jx < 16; ++jx) { const unsigned c = xb_ld((unsigned*)bar + XB_XCNT(jx)); ok = ok && (jx < 8 ? c == 32u : c == 0u); }
                    const unsigned rk = xb_ld((unsigned*)(ws + WS_CTL + 19456) + blockIdx.x), xc = xb_xcc_id();
                    if (MK_TID() == 0) { LAS int* gl = (LAS int*)(lds + GRP_LDS); gl[0] = ok ? 1 : 0; gl[1] = (int)(xc + 8u * (rk >> 2)); gl[2] = (int)(rk & 3u); gl[3] = 2 * (l - l_lo); }
                    __syncthreads();
                }
                MK_GRP_LOAD();
                pg8::Gemm g{(const bf16_t*)(ws + WS_AQ), (const bf16_t*)(ws + WS_W + WO_BR), 3 * M, 3 * 1024, 512};
                BranchOrder S; S.S.init(M, 1024, (int)gridDim.x, (int)blockIdx.x); S.gm = gm_; S.gpm = gpm_; S.gj = gj_;
                EpiBranchMK E{(const unsigned char*)(ws + WS_GS), (bf16_t*)(ws + WS_MG)};
                pg8::gemm_phase<EpiBranchMK, BranchOrder, true, true>(lds, g, S, E, MK_TID());
            }
            { MK_GRP_LOAD(); MK_GRP_SYNC(5); }
        }
        if ((MK_EN & PH_OUT) && (pmask & PH_OUT)) {
            KARGS(ka); unsigned char* ws = ka->ws;
            MK_GRP_LOAD();
            pg8::Gemm g{(const bf16_t*)(ws + WS_MG), (const bf16_t*)(ws + WS_W + WO_OUT), M, 1024, 1024}; GSched S; S.S.init(M, 1024, (int)gridDim.x, (int)blockIdx.x); S.gm = gm_; S.pm = gpm_; S.pn0 = gj_; S.n = 1;
            EpiResMK E{(l == 0) ? ka->in[0] : (const float*)ka->out, ka->out, ka->in[6] + (size_t)l * DMODEL, (bf16_t*)(ws + WS_XG), (float*)(ws + WS_SSQ)};
            pg8::gemm_phase<EpiResMK, GSched, true, true>(lds, g, S, E, MK_TID());
            GRID_SYNC_I(6);
        }
        for (int rep_ = 0; rep_ < ((MK_DBL & PH_FF1) ? 2 : 1); ++rep_)
        if ((MK_EN & PH_FF1) && (pmask & PH_FF1)) {
            KARGS(ka); unsigned char* ws = ka->ws;
            MK_GRP_LOAD();
            pg8::Gemm g{(const bf16_t*)(ws + WS_XG), (const bf16_t*)(ws + WS_W + WO_FF1), M, DFF, DMODEL}; GSched S; S.S.init(M, DFF, (int)gridDim.x, (int)blockIdx.x); S.gm = gm_; S.pm = gpm_; S.pn0 = 4 * gj_; S.n = 4;
            fill_rstd_table(S, (const float*)(ws + WS_SSQ), lds, MK_TID());
            EpiActMK<1> E{(const LAS float*)(lds + RSTD_TAB_OFF), (bf16_t*)(ws + WS_U), DFF};
            pg8::gemm_phase<EpiActMK<1>, GSched, true, true>(lds, g, S, E, MK_TID(), (unsigned long long*)(ws + WS_CTL + 24576));
            MK_GRP_SYNC(7);
        }
        if ((MK_EN & PH_FF2) && (pmask & PH_FF2)) {
            KARGS(ka); unsigned char* ws = ka->ws;
            MK_GRP_LOAD();
            pg8::Gemm g{(const bf16_t*)(ws + WS_U), (const bf16_t*)(ws + WS_W + WO_FF2), M, 1024, DFF}; GSched S; S.S.init(M, 1024, (int)gridDim.x, (int)blockIdx.x); S.gm = gm_; S.pm = gpm_; S.pn0 = gj_; S.n = 1;
            if (ka->fin && l + 1 == l_hi && (int)gridDim.x == (M / 256) * (DMODEL / 256)) {
                const int n_ = __builtin_amdgcn_readfirstlane(((LAS int*)(lds + GRP_LDS))[3]) + 1;
                EpiResFinalMK E{(const float*)ka->out, ka->out, ka->in[9], (float*)(ws + WS_SSQ), (unsigned*)(ws + WS_CTL), gm_ ? (unsigned*)(ws + WS_CTL + CTL_GRP) + 16 * gpm_ : nullptr, 4u * (unsigned)n_};
                pg8::gemm_phase<EpiResFinalMK, GSched, true, true>(lds, g, S, E, MK_TID());
                fin_done = true;
            } else {
            EpiResMK E{(const float*)ka->out, ka->out, (l + 1 < 2) ? ka->in[1] + (size_t)(l + 1) * DMODEL : nullptr, (bf16_t*)(ws + WS_XG), (float*)(ws + WS_SSQ)};
            pg8::gemm_phase<EpiResMK, GSched, true, true>(lds, g, S, E, MK_TID());
            if (!(MK_WQ && l + 1 < l_hi && (pmask & PH_PREP))) GRID_SYNC_I(8);
            }
        }
    }
#if defined(PG8_STAMP) || defined(MK_STAMP_SYNC) || defined(DSA_STAMP) || defined(MK_ARRIVE_PROBE)
    { KARGS(kp); if (blockIdx.x == 0 && MK_TID() == 0) { unsigned long long acc_ = __hip_atomic_load((unsigned long long*)(kp->ws + WS_CTL + 24576), __ATOMIC_RELAXED, __HIP_MEMORY_SCOPE_AGENT);
 const unsigned long long t0_ = __builtin_amdgcn_s_memrealtime(); while (__builtin_amdgcn_s_memrealtime() - t0_ < acc_ * PG8_AMP) __builtin_amdgcn_s_sleep(8); } }
#endif
    {
        KARGS(ka);
        if (ka->fin && !fin_done) {
            PHASE_IDS();
            const int gw = blockIdx.x * 8 + wave, NGW = gridDim.x * 8;
            float* out = ka->out; const float* SSQ = (const float*)(ka->ws + WS_SSQ);
            const float4* gr = (const float4*)ka->in[9];
            float4 gg[4];
#pragma unroll
            for (int j = 0; j < 4; ++j) gg[j] = gr[lane + 64 * j];
            for (int m0 = gw; m0 < M; m0 += 2 * NGW) {
                float4 v[2][4]; float r2[2];
#pragma unroll
                for (int r = 0; r < 2; ++r) { const int m = (m0 + r * NGW < M) ? m0 + r * NGW : m0; const float4* xr = (const float4*)(out + (size_t)m * DMODEL); r2[r] = rstd_of(SSQ, m);
#pragma unroll
                    for (int j = 0; j < 4; ++j) v[r][j] = xr[lane + 64 * j]; }
#pragma unroll
                for (int r = 0; r < 2; ++r) { const int m = m0 + r * NGW; if (m < M) { float4* xr = (float4*)(out + (size_t)m * DMODEL);
#pragma unroll
                    for (int j = 0; j < 4; ++j) { float4 w = v[r][j]; const float q = r2[r]; w.x *= q * gg[j].x; w.y *= q * gg[j].y; w.z *= q * gg[j].z; w.w *= q * gg[j].w; xr[lane + 64 * j] = w; } } }
            }
        }
    }
}

extern "C" void kernel_launch(void* const* d_in, const int* in_sizes, int n_in, void* d_out, int out_size, void* d_ws, size_t ws_size, hipStream_t stream) {
    const float* x = (const float*)d_in[0];
    const float* norm1 = (const float*)d_in[1];
    const float* w_in = (const float*)d_in[2];
    const float* sinks = (const float*)d_in[3];
    const float* w_branch = (const float*)d_in[4];
    const float* w_out = (const float*)d_in[5];
    const float* norm2 = (const float*)d_in[6];
    const float* w_ff1 = (const float*)d_in[7];
    const float* w_ff2 = (const float*)d_in[8];
    const float* norm_f = (const float*)d_in[9];
    float* out = (float*)d_out;
    unsigned char* ws = (unsigned char*)d_ws;
    float* SSQ = (float*)(ws + WS_SSQ); float* IW = (float*)(ws + WS_IW); float* KMEAN = (float*)(ws + WS_KMEAN);
    float* COS = (float*)(ws + WS_COS); float* SIN = (float*)(ws + WS_SIN);
    bf16_t* XG = (bf16_t*)(ws + WS_XG);
    bf16_t *AQ = (bf16_t*)(ws + WS_AQ), *BQ = (bf16_t*)(ws + WS_BQ), *CQ = (bf16_t*)(ws + WS_CQ);
    bf16_t *AK = (bf16_t*)(ws + WS_AK), *AV = (bf16_t*)(ws + WS_AV), *IQ = (bf16_t*)(ws + WS_IQ), *IK = (bf16_t*)(ws + WS_IK);
    bf16_t *BK = (bf16_t*)(ws + WS_BK), *BV = (bf16_t*)(ws + WS_BV), *CK = (bf16_t*)(ws + WS_CK), *CV = (bf16_t*)(ws + WS_CV);
    bf16_t *GS = (bf16_t*)(ws + WS_GS), *MG = (bf16_t*)(ws + WS_MG), *U = (bf16_t*)(ws + WS_U);
    unsigned short* SEL = (unsigned short*)(ws + WS_SEL);
    (void)w_in; (void)w_branch; (void)w_out; (void)w_ff1; (void)w_ff2; (void)norm1; (void)norm2; (void)norm_f; (void)x; (void)XG; (void)SSQ; (void)GS; (void)MG; (void)U; (void)COS; (void)SIN; (void)IW;

    static int grid = 0;
    if (grid == 0) {
        int dev = 0, cus = 0, per_cu = 0;
        hipGetDevice(&dev);
        hipDeviceGetAttribute(&cus, hipDeviceAttributeMultiprocessorCount, dev);
        hipFuncSetAttribute((const void*)mk_fwd, hipFuncAttributeMaxDynamicSharedMemorySize, MK_LDS);
        hipOccupancyMaxActiveBlocksPerMultiprocessor(&per_cu, (const void*)mk_fwd, 512, MK_LDS);
        if (per_cu < 1) per_cu = 1;
        grid = cus;
        (void)hipGetLastError();
    }
    auto launch_mk = [&](int l_lo, int l_hi, int pmask, int fin) {
        MKArgs a{};
        for (int i = 0; i < 10; ++i) a.in[i] = (const float*)d_in[i];
        a.out = out; a.ws = ws; a.l_lo = l_lo; a.l_hi = l_hi; a.pmask = pmask; a.fin = fin;
        void* args[] = {&a};
        hipMemsetAsync(ws + WS_CTL, 0, CTL_ZERO_BYTES, stream);
        hipLaunchCooperativeKernel((const void*)mk_fwd, dim3(grid), dim3(512), args, MK_LDS, stream);
    };
    launch_mk(0, 2, 0x1ff, 1);
}
```
